# Optimizing an MI355X kernel written in HIP

```python
import jax, jax.numpy as jnp
from jax import lax
import numpy as np

D_MODEL = 1024
BATCH = 32
SEQ = 2048
DEPTH = 1

CHUNK = 64
EXPAND = 2
E_TOTAL = EXPAND * D_MODEL
E_POOL = E_TOTAL // 2
E_CONV = E_TOTAL // 2
POOL_WINDOWS = (2, 4, 8, 16)
N_POOL_GROUPS = len(POOL_WINDOWS)
POOL_GROUP = E_POOL // N_POOL_GROUPS
CONV_K = 3
N_BRANCHES = 2
RMS_EPS = 1e-6

IN_SPLITS = (E_POOL, E_POOL,
             E_CONV, E_CONV, E_CONV, E_CONV,
             D_MODEL, D_MODEL)
IN_WIDTH = sum(IN_SPLITS)

kernel_name = "hybrid_pool_shortconv_gated_merge_adaln"


def rmsnorm(x, g):
    xf = x.astype(jnp.float32)
    r = lax.rsqrt(jnp.mean(xf * xf, axis=-1, keepdims=True) + RMS_EPS)
    return (xf * r).astype(x.dtype) * g


def split_cols(z):
    idx = np.cumsum(IN_SPLITS)[:-1].tolist()
    return jnp.split(z, idx, axis=-1)


def multiscale_pool_residual(u, pool_w):
    b, s, _ = u.shape
    uf = u.astype(jnp.float32)
    cs = jnp.pad(jnp.cumsum(uf, axis=1), ((0, 0), (1, 0), (0, 0)))
    pos = jnp.arange(1, s + 1, dtype=jnp.float32)
    groups = []
    for gi, w in enumerate(POOL_WINDOWS):
        sl = slice(gi * POOL_GROUP, (gi + 1) * POOL_GROUP)
        c_g = cs[:, :, sl]
        lagged = jnp.pad(c_g, ((0, 0), (w, 0), (0, 0)))[:, : s + 1]
        wsum = c_g[:, 1:] - lagged[:, 1:]
        cnt = jnp.minimum(pos, float(w))[None, :, None]
        groups.append(wsum / cnt - uf[:, :, sl])
    pooled = jnp.stack(groups, axis=2)
    mixed = jnp.einsum("bsgi,gio->bsgo", pooled, pool_w.astype(jnp.float32))
    return mixed.reshape(b, s, E_POOL).astype(u.dtype)


def causal_depthwise_conv(v, k, bias):
    s = v.shape[1]
    vp = jnp.pad(v, ((0, 0), (CONV_K - 1, 0), (0, 0)))
    out = bias
    for j in range(CONV_K):
        out = out + vp[:, j:j + s] * k[j]
    return out


def setup_inputs(seed: int = 0) -> dict:
    key = jax.random.key(seed)
    ks = jax.random.split(key, 16)
    f32 = jnp.float32
    nrm = lambda k, shape, sc: jax.random.normal(k, shape, f32) * sc
    return {
        "x": nrm(ks[0], (BATCH, SEQ, D_MODEL), 1.0),
        "c": nrm(ks[1], (BATCH, D_MODEL), 1.0),
        "ada_w": nrm(ks[2], (DEPTH, D_MODEL, 3 * D_MODEL), 0.2 * D_MODEL ** -0.5),
        "ada_b": nrm(ks[3], (DEPTH, 3 * D_MODEL), 0.02),
        "norm_g": 1.0 + nrm(ks[4], (DEPTH, D_MODEL), 0.05),
        "w_in": nrm(ks[5], (DEPTH, D_MODEL, IN_WIDTH), D_MODEL ** -0.5),
        "b_in": nrm(ks[6], (DEPTH, IN_WIDTH), 0.02),
        "pool_w": nrm(ks[7], (DEPTH, N_POOL_GROUPS, POOL_GROUP, POOL_GROUP), POOL_GROUP ** -0.5),
        "pool_scale": 1.0 + nrm(ks[8], (DEPTH, E_POOL), 0.1),
        "conv_w": nrm(ks[9], (DEPTH, CONV_K, E_CONV), CONV_K ** -0.5),
        "conv_b": nrm(ks[10], (DEPTH, E_CONV), 0.02),
        "w_out_a": nrm(ks[11], (DEPTH, E_POOL, D_MODEL), E_POOL ** -0.5),
        "w_out_b": nrm(ks[12], (DEPTH, E_CONV, D_MODEL), E_CONV ** -0.5),
        "w_o": nrm(ks[13], (DEPTH, D_MODEL, D_MODEL), D_MODEL ** -0.5),
        "final_g": 1.0 + nrm(ks[14], (D_MODEL,), 0.05),
    }


def reference(x, c, ada_w, ada_b, norm_g, w_in, b_in, pool_w, pool_scale,
              conv_w, conv_b, w_out_a, w_out_b, w_o, final_g):
    c_act = jax.nn.silu(c)
    for l in range(DEPTH):
        mod = c_act @ ada_w[l] + ada_b[l]
        shift, scale, gate = jnp.split(mod, 3, axis=-1)
        h = rmsnorm(x, norm_g[l]) * (1.0 + scale[:, None, :]) + shift[:, None, :]

        z = h @ w_in[l] + b_in[l]
        a_v, a_g, b_B, b_C, b_v, b_g, m_a, m_b = split_cols(z)

        y_a = multiscale_pool_residual(a_v, pool_w[l]) * pool_scale[l] * jax.nn.silu(a_g)
        o_a = y_a @ w_out_a[l]

        y_b = b_B * causal_depthwise_conv(b_C * b_v, conv_w[l], conv_b[l]) * jax.nn.silu(b_g)
        o_b = y_b @ w_out_b[l]

        merged = jax.nn.sigmoid(m_a) * o_a + jax.nn.sigmoid(m_b) * o_b
        x = x + gate[:, None, :] * (merged @ w_o[l])
    return rmsnorm(x, final_g)
```

```cpp
#include <hip/hip_runtime.h>
#include <stdint.h>

namespace {
constexpr int D = 1024, NB = 32, SEQ = 2048, T = NB * SEQ, INW = 8192;
constexpr int TC = 8192;
constexpr float EPS = 1e-6f;

__device__ __forceinline__ float silu_f(float v) { return v / (1.f + __expf(-v)); }
__device__ __forceinline__ float sigm_f(float v) { return 1.f / (1.f + __expf(-v)); }

__global__ void k_mod(const float* c, const float* ada_w, const float* ada_b, float* mod) {
    int j = blockIdx.x * blockDim.x + threadIdx.x; int b = blockIdx.y;
    if (j >= 3 * D) return;
    float s = 0.f;
    for (int k = 0; k < D; ++k) s += silu_f(c[b * D + k]) * ada_w[(size_t)k * 3 * D + j];
    mod[b * 3 * D + j] = s + ada_b[j];
}

__device__ __forceinline__ float block_sum256(float v, float* sh) {
    for (int o = 32; o >= 1; o >>= 1) v += __shfl_xor(v, o);
    int w = threadIdx.x >> 6;
    __syncthreads();
    if ((threadIdx.x & 63) == 0) sh[w] = v;
    __syncthreads();
    return sh[0] + sh[1] + sh[2] + sh[3];
}

__global__ void k_h(const float* x, const float* norm_g, const float* mod, float* h, int t0) {
    __shared__ float sh[4];
    int t = t0 + blockIdx.x; int b = t / SEQ;
    const float* xr = x + (size_t)t * D;
    float v[4]; float s = 0.f;
    for (int i = 0; i < 4; ++i) { v[i] = xr[threadIdx.x + 256 * i]; s += v[i] * v[i]; }
    s = block_sum256(s, sh);
    float r = rsqrtf(s / D + EPS);
    for (int i = 0; i < 4; ++i) { int k = threadIdx.x + 256 * i;
        float sc = mod[b * 3 * D + D + k], sf = mod[b * 3 * D + k];
        h[(size_t)blockIdx.x * D + k] = v[i] * r * norm_g[k] * (1.f + sc) + sf; }
}

__global__ void __launch_bounds__(256) k_sgemm(const float* A, int lda, const float* B, int ldb, float* C, int ldc, const float* bias, int M, int N, int K) {
    __shared__ float As[16][64 + 4];
    __shared__ float Bs[16][64 + 4];
    int tx = threadIdx.x & 15, ty = threadIdx.x >> 4;
    int m0 = blockIdx.y * 64, n0 = blockIdx.x * 64;
    float acc[4][4] = {};
    for (int k0 = 0; k0 < K; k0 += 16) {
        for (int i = threadIdx.x; i < 64 * 16; i += 256) { int r = i >> 4, kk = i & 15; As[kk][r] = A[(size_t)(m0 + r) * lda + k0 + kk]; }
        for (int i = threadIdx.x; i < 64 * 16; i += 256) { int kk = i >> 6, cc = i & 63; Bs[kk][cc] = B[(size_t)(k0 + kk) * ldb + n0 + cc]; }
        __syncthreads();
#pragma unroll
        for (int kk = 0; kk < 16; ++kk) {
            float a[4], b[4];
#pragma unroll
            for (int i = 0; i < 4; ++i) { a[i] = As[kk][ty * 4 + i]; b[i] = Bs[kk][tx * 4 + i]; }
#pragma unroll
            for (int i = 0; i < 4; ++i)
#pragma unroll
                for (int j = 0; j < 4; ++j) acc[i][j] += a[i] * b[j];
        }
        __syncthreads();
    }
    for (int i = 0; i < 4; ++i) for (int j = 0; j < 4; ++j) { int n = n0 + tx * 4 + j;
        C[(size_t)(m0 + ty * 4 + i) * ldc + n] = acc[i][j] + (bias ? bias[n] : 0.f); }
}

__global__ void k_pool(const float* z, float* pooled) {
    int idx = blockIdx.x * blockDim.x + threadIdx.x;
    int tl = idx >> 10, c = idx & 1023; int s = tl % SEQ; int g = c >> 8; int w = 2 << g;
    float sum = 0.f; int cnt = 0;
    for (int j = 0; j < w; ++j) { if (s - j >= 0) { sum += z[(size_t)(tl - j) * INW + c]; ++cnt; } }
    pooled[idx] = sum / (float)cnt - z[(size_t)tl * INW + c];
}

__global__ void k_ya(const float* z, const float* mixed, const float* pool_scale, float* ya) {
    int idx = blockIdx.x * blockDim.x + threadIdx.x; int tl = idx >> 10, c = idx & 1023;
    ya[idx] = mixed[idx] * pool_scale[c] * silu_f(z[(size_t)tl * INW + 1024 + c]);
}

__global__ void k_yb(const float* z, const float* conv_w, const float* conv_b, float* yb) {
    int idx = blockIdx.x * blockDim.x + threadIdx.x; int tl = idx >> 10, c = idx & 1023; int s = tl % SEQ;
    const float* zr = z + (size_t)tl * INW;
    float acc = conv_b[c];
    for (int j = 0; j < 3; ++j) { int d = 2 - j;
        if (s - d >= 0) { const float* zz = zr - (size_t)d * INW; acc += zz[3072 + c] * zz[4096 + c] * conv_w[j * 1024 + c]; } }
    yb[idx] = zr[2048 + c] * acc * silu_f(zr[5120 + c]);
}

__global__ void k_merge(const float* z, const float* oa, const float* ob, float* merged) {
    int idx = blockIdx.x * blockDim.x + threadIdx.x; int tl = idx >> 10, c = idx & 1023;
    const float* zr = z + (size_t)tl * INW;
    merged[idx] = sigm_f(zr[6144 + c]) * oa[idx] + sigm_f(zr[7168 + c]) * ob[idx];
}

__global__ void k_final(const float* x, const float* o, const float* mod, const float* final_g, float* out, int t0) {
    __shared__ float sh[4];
    int t = t0 + blockIdx.x; int b = t / SEQ;
    float v[4]; float s = 0.f;
    for (int i = 0; i < 4; ++i) { int k = threadIdx.x + 256 * i;
        v[i] = x[(size_t)t * D + k] + mod[b * 3 * D + 2 * D + k] * o[(size_t)blockIdx.x * D + k]; s += v[i] * v[i]; }
    s = block_sum256(s, sh);
    float r = rsqrtf(s / D + EPS);
    for (int i = 0; i < 4; ++i) { int k = threadIdx.x + 256 * i; out[(size_t)t * D + k] = v[i] * r * final_g[k]; }
}
}

extern "C" void kernel_launch(void* const* d_in, const int* in_sizes, int n_in, void* d_out, int out_size, void* d_ws, size_t ws_size, hipStream_t stream) {
    const float* x = (const float*)d_in[0]; const float* c = (const float*)d_in[1]; const float* ada_w = (const float*)d_in[2]; const float* ada_b = (const float*)d_in[3];
    const float* norm_g = (const float*)d_in[4]; const float* w_in = (const float*)d_in[5]; const float* b_in = (const float*)d_in[6]; const float* pool_w = (const float*)d_in[7];
    const float* pool_scale = (const float*)d_in[8]; const float* conv_w = (const float*)d_in[9]; const float* conv_b = (const float*)d_in[10];
    const float* w_out_a = (const float*)d_in[11]; const float* w_out_b = (const float*)d_in[12]; const float* w_o = (const float*)d_in[13]; const float* final_g = (const float*)d_in[14];
    float* out = (float*)d_out;
    float* ws = (float*)d_ws;
    float* mod = ws;
    float* h = ws + (1 << 20);
    float* z = h + (size_t)TC * D;
    float* pooled = z + (size_t)TC * INW;
    float* mixed = pooled + (size_t)TC * D;
    float* ya = mixed + (size_t)TC * D;
    float* yb = ya + (size_t)TC * D;
    float* oa = yb + (size_t)TC * D;
    float* ob = oa + (size_t)TC * D;
    float* merged = pooled;
    float* o = mixed;
    hipLaunchKernelGGL(k_mod, dim3(3 * D / 256, NB), dim3(256), 0, stream, c, ada_w, ada_b, mod);
    const int EW = TC * D / 256;
    for (int t0 = 0; t0 < T; t0 += TC) {
        hipLaunchKernelGGL(k_h, dim3(TC), dim3(256), 0, stream, x, norm_g, mod, h, t0);
        hipLaunchKernelGGL(k_sgemm, dim3(INW / 64, TC / 64), dim3(256), 0, stream, h, D, w_in, INW, z, INW, b_in, TC, INW, D);
        hipLaunchKernelGGL(k_pool, dim3(EW), dim3(256), 0, stream, z, pooled);
        for (int g = 0; g < 4; ++g)
            hipLaunchKernelGGL(k_sgemm, dim3(256 / 64, TC / 64), dim3(256), 0, stream, pooled + g * 256, D, pool_w + (size_t)g * 256 * 256, 256, mixed + g * 256, D, (const float*)nullptr, TC, 256, 256);
        hipLaunchKernelGGL(k_ya, dim3(EW), dim3(256), 0, stream, z, mixed, pool_scale, ya);
        hipLaunchKernelGGL(k_yb, dim3(EW), dim3(256), 0, stream, z, conv_w, conv_b, yb);
        hipLaunchKernelGGL(k_sgemm, dim3(D / 64, TC / 64), dim3(256), 0, stream, ya, D, w_out_a, D, oa, D, (const float*)nullptr, TC, D, D);
        hipLaunchKernelGGL(k_sgemm, dim3(D / 64, TC / 64), dim3(256), 0, stream, yb, D, w_out_b, D, ob, D, (const float*)nullptr, TC, D, D);
        hipLaunchKernelGGL(k_merge, dim3(EW), dim3(256), 0, stream, z, oa, ob, merged);
        hipLaunchKernelGGL(k_sgemm, dim3(D / 64, TC / 64), dim3(256), 0, stream, merged, D, w_o, D, o, D, (const float*)nullptr, TC, D, D);
        hipLaunchKernelGGL(k_final, dim3(TC), dim3(256), 0, stream, x, o, mod, final_g, out, t0);
    }
}
```

```cpp
#include <hip/hip_runtime.h>
#include <hip/hip_cooperative_groups.h>
#include <cstdio>
#include <cstdint>
namespace cg = cooperative_groups;

#define LAS __attribute__((address_space(3)))
typedef unsigned short bf16_t;
typedef short bf16x8 __attribute__((ext_vector_type(8)));
typedef float f32x4 __attribute__((ext_vector_type(4)));
typedef unsigned u32x4 __attribute__((ext_vector_type(4)));

namespace {
constexpr int D = 1024, NB = 32, SEQ = 2048, T = NB * SEQ, INW = 8192;
constexpr float EPS = 1e-6f;
constexpr int NWAVES = 8, NTHREADS = 512;
constexpr int CH_TOK = 16384, NCHUNK = T / CH_TOK;
constexpr size_t MiB = 1u << 20;
constexpr size_t WS_MODP = 0;
constexpr size_t WS_GATE = 3 * MiB;
constexpr size_t WS_BIAS1 = WS_GATE + 131072;
constexpr size_t WS_PART = 4 * MiB;
constexpr size_t WS_W1T = 8 * MiB;
constexpr size_t WS_WABT = 24 * MiB;
constexpr size_t WS_WOT = 28 * MiB;
constexpr size_t WS_H = 32 * MiB;
constexpr size_t WS_Y = 160 * MiB;
constexpr size_t WS_R = 416 * MiB;
constexpr size_t WS_SB = 544 * MiB;
constexpr size_t WS_Z = 672 * MiB;
constexpr size_t WS_END = 928 * MiB;
constexpr int LDS_BYTES = 147456;

__device__ __forceinline__ unsigned f2bf(float f) { unsigned u = __builtin_bit_cast(unsigned, f); return (u + 0x7fffu + ((u >> 16) & 1u)) >> 16; }
__device__ __forceinline__ unsigned pk2(float lo, float hi) { return f2bf(lo) | (f2bf(hi) << 16); }
__device__ __forceinline__ float bf2f(bf16_t b) { return __builtin_bit_cast(float, (unsigned)b << 16); }
__device__ __forceinline__ float bflo(unsigned w) { return __builtin_bit_cast(float, w << 16); }
__device__ __forceinline__ float bfhi(unsigned w) { return __builtin_bit_cast(float, w & 0xffff0000u); }
__device__ __forceinline__ unsigned cvt_pk_bf16(float lo, float hi) { unsigned r; asm volatile("v_cvt_pk_bf16_f32 %0, %1, %2" : "=v"(r) : "v"(lo), "v"(hi)); return r; }
__device__ __forceinline__ float silu_f(float v) { return v / (1.f + __expf(-v)); }
#define LDS_WAIT() asm volatile("s_waitcnt lgkmcnt(0)" ::: "memory")

__device__ __forceinline__ int src_col(int L) {
    const int pn = L >> 8, lc = L & 255;
    if (pn < 8) return lc < 128 ? -(1 + pn * 128 + lc) : 1024 + pn * 128 + (lc - 128);
    if (pn < 24) { const int q = pn - 8, half = lc >> 7, wc = (lc >> 5) & 3, n = (lc >> 2) & 1, i = (((lc >> 3) & 3) << 2) | (lc & 3);
        const int ch = q * 64 + wc * 16 + i; const int seg = half ? (n ? 5120 : 2048) : (n ? 4096 : 3072); return seg + ch; }
    const int q = pn - 24; return lc < 128 ? 6144 + q * 128 + lc : 7168 + q * 128 + (lc - 128);
}

namespace pg8 {
constexpr int BM = 256, BK = 64, HALF = 128, HTB = HALF * BK * 2, STAGE_BYTES = 8 * HTB, NXCD = 8, WGM = 8;
__device__ __forceinline__ int lds_byte(int r, int c) { const int st = (r >> 4) * 2 + (c >> 5), rr = r & 15, cc = c & 31, ob = rr * 64 + cc * 2; return st * 1024 + (ob ^ (((ob >> 9) & 1) << 5)); }
__device__ __forceinline__ void stage_rc(int b, int& R, int& C) { const int st = b / 1024, sb = b % 1024, swz = sb ^ (((sb >> 9) & 1) << 5); R = (st >> 1) * 16 + swz / 64; C = (st & 1) * 32 + (swz % 64) / 2; }
__device__ __forceinline__ int perm32(int rho) { const int n = rho >> 4, i = rho & 15; return 8 * (i >> 2) + 4 * n + (i & 3); }
struct Unit { int pm, pn; };
struct Gemm { const bf16_t* A; const bf16_t* Bt; int M, N, K; };
struct StaticOrder {
    int nM, nN, nwg, G, c;
    __device__ void init(int M, int N, int G_, int c_) { nM = M / BM; nN = N / BM; nwg = nM * nN; G = G_; c = c_; }
    __device__ bool next(int i, Unit& u) const {
        const long L = (long)i * G + c; if (L >= nwg) return false;
        int wgid = (int)L; { const int q = nwg / NXCD, r = nwg % NXCD, xcd = wgid % NXCD, off = wgid / NXCD; wgid = (xcd < r ? xcd * (q + 1) : r * (q + 1) + (xcd - r) * q) + off; }
        const int nig = WGM * nN, gid = wgid / nig, fm = gid * WGM, gsz = (nM - fm) < WGM ? (nM - fm) : WGM;
        u.pm = fm + ((wgid % nig) % gsz); u.pn = (wgid % nig) / gsz; return true;
    }
};

struct EpiZ {
    static constexpr bool PERM = true, MID = false;
    bf16_t* O; int ldc; const float* bias;
    __device__ __forceinline__ void mid(f32x4 (&)[2][2][4][2], const Unit&, int, int, int, int) const {}
    __device__ __forceinline__ void operator()(f32x4 (&acc)[2][2][4][2], const Unit& u, int wr, int wc, int fr, int fq) const {
        const int row0 = u.pm * BM + wr * 64 + fr, col0 = u.pn * BM + wc * 32 + 8 * fq;
        f32x4 bv[2][2];
#pragma unroll
        for (int bj = 0; bj < 2; ++bj)
#pragma unroll
            for (int n = 0; n < 2; ++n) bv[bj][n] = *(const f32x4*)(bias + col0 + bj * HALF + 4 * n);
#pragma unroll
        for (int ai = 0; ai < 2; ++ai)
#pragma unroll
            for (int m = 0; m < 4; ++m) { bf16_t* rowp = O + (size_t)(row0 + ai * HALF + m * 16) * ldc + col0;
#pragma unroll
                for (int bj = 0; bj < 2; ++bj) { const f32x4 v0 = acc[ai][bj][m][0] + bv[bj][0], v1 = acc[ai][bj][m][1] + bv[bj][1];
                    u32x4 w; w.x = cvt_pk_bf16(v0[0], v0[1]); w.y = cvt_pk_bf16(v0[2], v0[3]); w.z = cvt_pk_bf16(v1[0], v1[1]); w.w = cvt_pk_bf16(v1[2], v1[3]);
                    *(u32x4*)(rowp + bj * HALF) = w; } }
    }
};
struct EpiMerge {
    static constexpr bool PERM = true, MID = true;
    const bf16_t* R; const bf16_t* SB; bf16_t* O;
    __device__ __forceinline__ void mid(f32x4 (&acc)[2][2][4][2], const Unit& u, int wr, int wc, int fr, int fq) const {
        const int row0 = u.pm * BM + wr * 64 + fr, col0 = u.pn * BM + wc * 32 + 8 * fq;
#pragma unroll
        for (int ai = 0; ai < 2; ++ai)
#pragma unroll
            for (int m = 0; m < 4; ++m) { const bf16_t* rp = R + (size_t)(row0 + ai * HALF + m * 16) * D + col0;
#pragma unroll
                for (int bj = 0; bj < 2; ++bj) { const u32x4 w = *(const u32x4*)(rp + bj * HALF);
                    acc[ai][bj][m][0] *= (f32x4){bflo(w.x), bfhi(w.x), bflo(w.y), bfhi(w.y)};
                    acc[ai][bj][m][1] *= (f32x4){bflo(w.z), bfhi(w.z), bflo(w.w), bfhi(w.w)}; } }
    }
    __device__ __forceinline__ void operator()(f32x4 (&acc)[2][2][4][2], const Unit& u, int wr, int wc, int fr, int fq) const {
        const int row0 = u.pm * BM + wr * 64 + fr, col0 = u.pn * BM + wc * 32 + 8 * fq;
#pragma unroll
        for (int ai = 0; ai < 2; ++ai)
#pragma unroll
            for (int m = 0; m < 4; ++m) { const size_t off = (size_t)(row0 + ai * HALF + m * 16) * D + col0;
#pragma unroll
                for (int bj = 0; bj < 2; ++bj) { const u32x4 s = *(const u32x4*)(SB + off + bj * HALF);
                    const f32x4 v0 = acc[ai][bj][m][0] * (f32x4){bflo(s.x), bfhi(s.x), bflo(s.y), bfhi(s.y)};
                    const f32x4 v1 = acc[ai][bj][m][1] * (f32x4){bflo(s.z), bfhi(s.z), bflo(s.w), bfhi(s.w)};
                    u32x4 w; w.x = cvt_pk_bf16(v0[0], v0[1]); w.y = cvt_pk_bf16(v0[2], v0[3]); w.z = cvt_pk_bf16(v1[0], v1[1]); w.w = cvt_pk_bf16(v1[2], v1[3]);
                    *(u32x4*)(O + off + bj * HALF) = w; } }
    }
};
struct EpiXnew {
    static constexpr bool PERM = false, MID = false;
    const float* x; const float* gate; float* out; float* part;
    __device__ __forceinline__ void mid(f32x4 (&)[2][2][4][2], const Unit&, int, int, int, int) const {}
    __device__ __forceinline__ void operator()(f32x4 (&acc)[2][2][4][2], const Unit& u, int wr, int wc, int fr, int fq) const {
        const int row0 = u.pm * BM + wr * 64 + fr, col0 = u.pn * BM + wc * 32 + 4 * fq; const int b = u.pm >> 3;
        f32x4 gv[2][2];
#pragma unroll
        for (int bj = 0; bj < 2; ++bj)
#pragma unroll
            for (int n = 0; n < 2; ++n) gv[bj][n] = *(const f32x4*)(gate + b * D + col0 + bj * HALF + n * 16);
#pragma unroll
        for (int ai = 0; ai < 2; ++ai)
#pragma unroll
            for (int m = 0; m < 4; ++m) { const int row = row0 + ai * HALF + m * 16; const size_t off = (size_t)row * D + col0; float s = 0.f;
#pragma unroll
                for (int bj = 0; bj < 2; ++bj)
#pragma unroll
                    for (int n = 0; n < 2; ++n) { const f32x4 xv = *(const f32x4*)(x + off + bj * HALF + n * 16); const f32x4 o = xv + gv[bj][n] * acc[ai][bj][m][n];
                        *(f32x4*)(out + off + bj * HALF + n * 16) = o; s += (o[0] * o[0] + o[1] * o[1]) + (o[2] * o[2] + o[3] * o[3]); }
                s += __shfl_xor(s, 16); s += __shfl_xor(s, 32);
                if (fq == 0) part[(size_t)row * 16 + u.pn * 4 + wc] = s;
                asm volatile("" ::: "memory"); }
    }
};

template <class Epi, class Sched, bool ALIGN_EPI = true, bool SP2 = true>
__device__ __forceinline__ void gemm_phase(LAS unsigned char* lds, const Gemm g, const Sched& S, const Epi& E) {
    const int tid = threadIdx.x, wid = __builtin_amdgcn_readfirstlane(tid >> 6), lane = tid & 63, wr = wid >> 2, wc = wid & 3, fr = lane & 15, fq = lane >> 4;
    const int K = g.K, nt = K / BK;
    unsigned voffA[2], voffB[2];
#pragma unroll
    for (int i = 0; i < 2; ++i) { int R, C; stage_rc(tid * 16 + i * 8192, R, C); const int Rb = Epi::PERM ? ((R & ~31) + perm32(R & 31)) : R;
        voffA[i] = (unsigned)(R * K + C) * 2u; voffB[i] = (unsigned)(Rb * K + C) * 2u; }
    const size_t kstep = (size_t)(BK * 2);
    const size_t hstep = (size_t)HALF * K * 2;
    const size_t tstep = 2 * hstep;
    const unsigned ldsw = (unsigned)wid * 1024u;
    const int aoff = lds_byte(wr * 64 + fr, fq * 8), boff = lds_byte(wc * 32 + fr, fq * 8);
#define PG8_SA(b, h) (((b) * 2 + (h)) * HTB)
#define PG8_SB(b, h) ((4 + (b) * 2 + (h)) * HTB)
#define PG8_STAGE(bufoff, gbase, voff) do { _Pragma("unroll") for (int _i = 0; _i < 2; ++_i) \
        __builtin_amdgcn_global_load_lds((const unsigned*)((const char*)(gbase) + (voff)[_i]), (LAS unsigned*)(lds + (bufoff) + ldsw + _i * 8192), 16, 0, 0); } while (0)
#define PG8_LDA(dst, b, h) do { _Pragma("unroll") for (int m = 0; m < 4; ++m) _Pragma("unroll") for (int k = 0; k < 2; ++k) dst[m][k] = *(const LAS bf16x8*)(lds + PG8_SA(b, h) + aoff + m * 2048 + k * 1024); } while (0)
#define PG8_LDB(dst, b, h) do { _Pragma("unroll") for (int n = 0; n < 2; ++n) _Pragma("unroll") for (int k = 0; k < 2; ++k) dst[n][k] = *(const LAS bf16x8*)(lds + PG8_SB(b, h) + boff + n * 2048 + k * 1024); } while (0)
#define PG8_MMA(ai, bj, At, Bt) do { __builtin_amdgcn_s_setprio(1); _Pragma("unroll") for (int m = 0; m < 4; ++m) _Pragma("unroll") for (int n = 0; n < 2; ++n) _Pragma("unroll") for (int k = 0; k < 2; ++k) \
        acc[ai][bj][m][n] = __builtin_amdgcn_mfma_f32_16x16x32_bf16(Bt[n][k], At[m][k], acc[ai][bj][m][n], 0, 0, 0); __builtin_amdgcn_s_setprio(0); } while (0)
#define PG8_WAIT_V(n) asm volatile("s_waitcnt vmcnt(" #n ")" ::: "memory")
#define PG8_WAIT_L(n) asm volatile("s_waitcnt lgkmcnt(" #n ")" ::: "memory")
#define PG8_BAR __builtin_amdgcn_s_barrier()
#define PG8_SCHED __builtin_amdgcn_sched_barrier(0)
    Unit cur, nxt; int ui = 0;
    if (!S.next(0, cur)) return;
    f32x4 acc[2][2][4][2];
#pragma unroll
    for (int a = 0; a < 2; ++a)
#pragma unroll
        for (int b = 0; b < 2; ++b)
#pragma unroll
            for (int m = 0; m < 4; ++m)
#pragma unroll
                for (int n = 0; n < 2; ++n) acc[a][b][m][n] = (f32x4){0.f, 0.f, 0.f, 0.f};
    bf16x8 At[4][2], B0[2][2], B1[2][2];
    const char* cA = (const char*)g.A + (size_t)cur.pm * tstep; const char* cB = (const char*)g.Bt + (size_t)cur.pn * tstep;
    if constexpr (SP2) {
        PG8_STAGE(PG8_SB(0, 0), cB, voffB); PG8_STAGE(PG8_SB(0, 1), cB + hstep, voffB); PG8_STAGE(PG8_SA(0, 0), cA, voffA); PG8_STAGE(PG8_SA(0, 1), cA + hstep, voffA);
        if (wr == 1) PG8_BAR;
        PG8_WAIT_V(2); PG8_BAR;
        PG8_STAGE(PG8_SB(1, 0), cB + kstep, voffB); PG8_STAGE(PG8_SA(1, 0), cA + kstep, voffA); PG8_STAGE(PG8_SB(1, 1), cB + hstep + kstep, voffB);
        PG8_WAIT_V(6); PG8_BAR;
    } else {
        PG8_STAGE(PG8_SB(0, 0), cB, voffB); PG8_STAGE(PG8_SA(0, 0), cA, voffA); PG8_STAGE(PG8_SB(0, 1), cB + hstep, voffB); PG8_STAGE(PG8_SA(0, 1), cA + hstep, voffA);
        if (wr == 1) PG8_BAR;
        PG8_WAIT_V(4); PG8_BAR;
        PG8_STAGE(PG8_SB(1, 0), cB + kstep, voffB); PG8_STAGE(PG8_SA(1, 0), cA + kstep, voffA); PG8_STAGE(PG8_SB(1, 1), cB + hstep + kstep, voffB);
        PG8_WAIT_V(6); PG8_BAR;
    }
    for (;;) {
        const bool has_next = S.next(ui + 1, nxt);
        const char* nA = has_next ? (const char*)g.A + (size_t)nxt.pm * tstep : cA; const char* nB = has_next ? (const char*)g.Bt + (size_t)nxt.pn * tstep : cB;
        for (int t = 0; t < nt; t += 2) {
            const bool last = (t == nt - 2);
            const char* a1 = cA + (size_t)(t + 1) * kstep;
            const char* a2 = last ? nA : cA + (size_t)(t + 2) * kstep; const char* b2 = last ? nB : cB + (size_t)(t + 2) * kstep;
            const char* a3 = a2 + kstep; const char* b3 = b2 + kstep;
            if constexpr (Epi::MID) { if (t == (nt >> 1)) { int fr2 = fr, fq2 = fq; asm volatile("" : "+v"(fr2), "+v"(fq2)); E.mid(acc, cur, wr, wc, fr2, fq2); } }
            if constexpr (SP2) {
            PG8_LDB(B0, 0, 0); PG8_LDB(B1, 0, 1); PG8_SCHED; PG8_LDA(At, 0, 0); PG8_STAGE(PG8_SA(1, 1), a1 + hstep, voffA);
            PG8_WAIT_V(8); PG8_WAIT_L(0); PG8_BAR; PG8_MMA(0, 0, At, B0); PG8_MMA(0, 1, At, B1); PG8_BAR; PG8_SCHED;
            PG8_LDA(At, 0, 1); PG8_STAGE(PG8_SB(0, 0), b2, voffB); PG8_STAGE(PG8_SB(0, 1), b2 + hstep, voffB); PG8_STAGE(PG8_SA(0, 0), a2, voffA);
            PG8_WAIT_V(8); PG8_WAIT_L(0); PG8_BAR; PG8_MMA(1, 0, At, B0); PG8_MMA(1, 1, At, B1); PG8_BAR; PG8_SCHED;
            PG8_LDB(B0, 1, 0); PG8_LDB(B1, 1, 1); PG8_SCHED; PG8_LDA(At, 1, 0); PG8_STAGE(PG8_SA(0, 1), a2 + hstep, voffA);
            PG8_WAIT_V(8); PG8_WAIT_L(0); PG8_BAR; PG8_MMA(0, 0, At, B0); PG8_MMA(0, 1, At, B1); PG8_BAR; PG8_SCHED;
            PG8_LDA(At, 1, 1); PG8_STAGE(PG8_SB(1, 0), b3, voffB); PG8_STAGE(PG8_SB(1, 1), b3 + hstep, voffB); PG8_STAGE(PG8_SA(1, 0), a3, voffA);
            PG8_WAIT_V(8); PG8_WAIT_L(0); PG8_BAR; PG8_MMA(1, 0, At, B0); PG8_MMA(1, 1, At, B1); PG8_BAR; PG8_SCHED;
            } else {
            PG8_LDB(B0, 0, 0); PG8_SCHED; PG8_LDA(At, 0, 0); PG8_STAGE(PG8_SA(1, 1), a1 + hstep, voffA);
            PG8_WAIT_L(8); PG8_BAR; PG8_WAIT_L(0); PG8_MMA(0, 0, At, B0); PG8_BAR; PG8_SCHED;
            PG8_LDB(B1, 0, 1); PG8_STAGE(PG8_SB(0, 0), b2, voffB);
            PG8_BAR; PG8_WAIT_L(0); PG8_MMA(0, 1, At, B1); PG8_BAR;
            PG8_LDA(At, 0, 1); PG8_STAGE(PG8_SA(0, 0), a2, voffA);
            PG8_BAR; PG8_WAIT_L(0); PG8_MMA(1, 0, At, B0); PG8_BAR; PG8_SCHED;
            PG8_STAGE(PG8_SB(0, 1), b2 + hstep, voffB);
            PG8_WAIT_V(6); PG8_BAR; PG8_MMA(1, 1, At, B1); PG8_BAR;
            PG8_LDB(B0, 1, 0); PG8_SCHED; PG8_LDA(At, 1, 0); PG8_STAGE(PG8_SA(0, 1), a2 + hstep, voffA);
            PG8_WAIT_L(8); PG8_BAR; PG8_WAIT_L(0); PG8_MMA(0, 0, At, B0); PG8_BAR; PG8_SCHED;
            PG8_LDB(B1, 1, 1); PG8_STAGE(PG8_SB(1, 0), b3, voffB);
            PG8_BAR; PG8_WAIT_L(0); PG8_MMA(0, 1, At, B1); PG8_BAR;
            PG8_LDA(At, 1, 1); PG8_STAGE(PG8_SA(1, 0), a3, voffA);
            PG8_BAR; PG8_WAIT_L(0); PG8_MMA(1, 0, At, B0); PG8_BAR; PG8_SCHED;
            PG8_STAGE(PG8_SB(1, 1), b3 + hstep, voffB);
            PG8_WAIT_V(6); PG8_BAR; PG8_MMA(1, 1, At, B1); PG8_BAR;
            }
        }
        if constexpr (ALIGN_EPI) { if (wr == 0) PG8_BAR; }
        { int fr2 = fr, fq2 = fq; asm volatile("" : "+v"(fr2), "+v"(fq2)); E(acc, cur, wr, wc, fr2, fq2); }
        if (!has_next) break;
#pragma unroll
        for (int a = 0; a < 2; ++a)
#pragma unroll
            for (int b = 0; b < 2; ++b)
#pragma unroll
                for (int m = 0; m < 4; ++m)
#pragma unroll
                    for (int n = 0; n < 2; ++n) acc[a][b][m][n] = (f32x4){0.f, 0.f, 0.f, 0.f};
        cur = nxt; cA = nA; cB = nB; ++ui;
        if constexpr (ALIGN_EPI) { if (wr == 1) PG8_BAR; }
    }
    PG8_WAIT_V(0);
    if constexpr (!ALIGN_EPI) { if (wr == 0) PG8_BAR; }
    PG8_BAR;
#undef PG8_SA
#undef PG8_SB
#undef PG8_STAGE
#undef PG8_LDA
#undef PG8_LDB
#undef PG8_MMA
#undef PG8_WAIT_V
#undef PG8_WAIT_L
#undef PG8_BAR
#undef PG8_SCHED
}
}

struct Args {
    const float *x, *c, *ada_w, *ada_b, *norm_g, *w_in, *b_in, *pool_w, *pool_scale, *conv_w, *conv_b, *w_out_a, *w_out_b, *w_o, *final_g;
    float* out; unsigned char* ws;
};

__device__ __forceinline__ void p0_fold(LAS unsigned char* lds, const Args& a, int blk) {
    LAS float* wt = (LAS float*)lds;
    LAS float* pt = wt + 64 * 257;
    const int tid = threadIdx.x;
    const int k0 = (blk & 15) * 64, o0 = (blk >> 4) * 64, g = o0 >> 8, oo = o0 & 255;
    for (int j = 0; j < 32; ++j) { const int idx = tid + 512 * j, kk = idx >> 8, i = idx & 255; wt[kk * 257 + i] = a.w_in[(size_t)(k0 + kk) * INW + g * 256 + i]; }
    for (int j = 0; j < 32; ++j) { const int idx = tid + 512 * j, i = idx >> 6, cc = idx & 63; pt[i * 64 + cc] = a.pool_w[(size_t)g * 65536 + i * 256 + oo + cc]; }
    __syncthreads();
    const int kk = tid & 63, oq = tid >> 6;
    float acc[8];
#pragma unroll
    for (int j = 0; j < 8; ++j) acc[j] = 0.f;
    for (int i = 0; i < 256; ++i) { const float av = wt[kk * 257 + i]; const f32x4 p0 = *(const LAS f32x4*)(pt + i * 64 + oq * 8), p1 = *(const LAS f32x4*)(pt + i * 64 + oq * 8 + 4);
        acc[0] += av * p0[0]; acc[1] += av * p0[1]; acc[2] += av * p0[2]; acc[3] += av * p0[3]; acc[4] += av * p1[0]; acc[5] += av * p1[1]; acc[6] += av * p1[2]; acc[7] += av * p1[3]; }
    bf16_t* W1t = (bf16_t*)(a.ws + WS_W1T);
#pragma unroll
    for (int j = 0; j < 8; ++j) { const int o = o0 + oq * 8 + j; const int L = 256 * (o >> 7) + (o & 127); W1t[(size_t)L * D + k0 + kk] = (bf16_t)f2bf(acc[j]); }
    __syncthreads();
}
__device__ __forceinline__ void p0_tr_item(const float* W, int ldw, int sc, bf16_t* WT, int ldt, int koff, LAS float* scr, int k0, int n0, int lane) {
#pragma unroll 8
    for (int i = 0; i < 32; ++i) { const int kk = 2 * i + (lane >> 5); scr[kk * 33 + (lane & 31)] = W[(size_t)(k0 + kk) * ldw + sc]; }
    LDS_WAIT();
    const int c = lane & 7;
#pragma unroll
    for (int j = 0; j < 4; ++j) { const int n = (lane >> 3) + 8 * j; const LAS float* s = scr + (8 * c) * 33 + n;
        u32x4 o; o.x = pk2(s[0 * 33], s[1 * 33]); o.y = pk2(s[2 * 33], s[3 * 33]); o.z = pk2(s[4 * 33], s[5 * 33]); o.w = pk2(s[6 * 33], s[7 * 33]);
        *(u32x4*)(WT + (size_t)(n0 + n) * ldt + koff + k0 + 8 * c) = o; }
    LDS_WAIT();
}
__device__ __forceinline__ void p0_mod_item(const Args& a, LAS float* scr  , int jc, int kc, int lane) {
    for (int j = 0; j < 64; ++j) { const int idx = lane + 64 * j, kk = idx & 127, b = idx >> 7; scr[b * 128 + kk] = silu_f(a.c[b * D + kc * 128 + kk]); }
    LDS_WAIT();
    float acc[32];
#pragma unroll
    for (int b = 0; b < 32; ++b) acc[b] = 0.f;
    const float* wp = a.ada_w + (size_t)(kc * 128) * 3072 + jc * 64 + lane;
    for (int k4 = 0; k4 < 32; ++k4) {
        const float w0 = wp[(size_t)(k4 * 4 + 0) * 3072], w1 = wp[(size_t)(k4 * 4 + 1) * 3072], w2 = wp[(size_t)(k4 * 4 + 2) * 3072], w3 = wp[(size_t)(k4 * 4 + 3) * 3072];
#pragma unroll
        for (int b = 0; b < 32; ++b) { const f32x4 s = *(const LAS f32x4*)(scr + b * 128 + k4 * 4); acc[b] += (s[0] * w0 + s[1] * w1) + (s[2] * w2 + s[3] * w3); }
    }
    float* part = (float*)(a.ws + WS_MODP);
#pragma unroll
    for (int b = 0; b < 32; ++b) part[(size_t)(kc * 32 + b) * 3072 + jc * 64 + lane] = acc[b];
    LDS_WAIT();
}
__device__ __forceinline__ void p0_prep(LAS unsigned char* lds, const Args& a) {
    const int tid = threadIdx.x, lane = tid & 63, wave = __builtin_amdgcn_readfirstlane(tid >> 6);
    const int G = gridDim.x, gw = blockIdx.x * NWAVES + wave, NGW = G * NWAVES;
    { const int gid = blockIdx.x * NTHREADS + tid; if (gid < INW) { const int sc = src_col(gid); ((float*)(a.ws + WS_BIAS1))[gid] = sc < 0 ? 0.f : a.b_in[sc]; } }
    for (int it = blockIdx.x; it < 256; it += G) p0_fold(lds, a, it);
    LAS float* scr = (LAS float*)(lds + wave * 16384);
    bf16_t* W1t = (bf16_t*)(a.ws + WS_W1T); bf16_t* WABt = (bf16_t*)(a.ws + WS_WABT); bf16_t* Wot = (bf16_t*)(a.ws + WS_WOT);
    constexpr int I_1 = 16 * 256, I_A = 16 * 32, I_MOD = 48 * 8;
    for (int it = gw; it < I_MOD; it += NGW) p0_mod_item(a, scr, it % 48, it / 48, lane);
    for (int it = gw; it < I_1 + 3 * I_A; it += NGW) {
        int r = it;
        if (r < I_1) { const int kb = r & 15, nb = r >> 4; const int sc = src_col(nb * 32 + (lane & 31)); if (sc >= 0) p0_tr_item(a.w_in, INW, sc, W1t, D, 0, scr, kb * 64, nb * 32, lane); continue; } r -= I_1;
        const int kb = r & 15, nb = (r >> 4) & 31, which = r >> 9;
        if (which == 0) p0_tr_item(a.w_out_a, D, nb * 32 + (lane & 31), WABt, 2 * D, 0, scr, kb * 64, nb * 32, lane);
        else if (which == 1) p0_tr_item(a.w_out_b, D, nb * 32 + (lane & 31), WABt, 2 * D, D, scr, kb * 64, nb * 32, lane);
        else p0_tr_item(a.w_o, D, nb * 32 + (lane & 31), Wot, D, 0, scr, kb * 64, nb * 32, lane);
    }
}

__device__ __forceinline__ float wave_sum(float v) {
#pragma unroll
    for (int o = 1; o < 64; o <<= 1) v += __shfl_xor(v, o);
    return v;
}
__device__ __forceinline__ void p1_h(const Args& a) {
    const int tid = threadIdx.x, lane = tid & 63, wave = tid >> 6;
    const int gw = blockIdx.x * NWAVES + wave, NGW = gridDim.x * NWAVES;
    const float* part = (const float*)(a.ws + WS_MODP);
    { const int gid = blockIdx.x * NTHREADS + tid; if (gid < NB * D) { const int b = gid >> 10, j = gid & 1023; float s = a.ada_b[2 * D + j];
        for (int kc = 0; kc < 8; ++kc) s += part[(size_t)(kc * 32 + b) * 3072 + 2 * D + j]; ((float*)(a.ws + WS_GATE))[gid] = s; } }
    bf16_t* H = (bf16_t*)(a.ws + WS_H);
    for (int rb = gw; rb < T / 32; rb += NGW) {
        const int b = (rb * 32) / SEQ;
        f32x4 gs[4], sh[4];
#pragma unroll
        for (int j = 0; j < 4; ++j) { const int k = 4 * lane + 256 * j; f32x4 sc = *(const f32x4*)(a.ada_b + D + k), sf = *(const f32x4*)(a.ada_b + k);
            for (int kc = 0; kc < 8; ++kc) { const float* p = part + (size_t)(kc * 32 + b) * 3072; sc += *(const f32x4*)(p + D + k); sf += *(const f32x4*)(p + k); }
            gs[j] = *(const f32x4*)(a.norm_g + k) * (sc + 1.f); sh[j] = sf; }
        for (int r = 0; r < 32; ++r) { const size_t row = (size_t)rb * 32 + r; const f32x4* xr = (const f32x4*)(a.x + row * D) + lane;
            f32x4 v[4]; float s = 0.f;
#pragma unroll
            for (int j = 0; j < 4; ++j) { v[j] = xr[64 * j]; s += (v[j][0] * v[j][0] + v[j][1] * v[j][1]) + (v[j][2] * v[j][2] + v[j][3] * v[j][3]); }
            const float rstd = rsqrtf(wave_sum(s) * (1.f / D) + EPS);
            unsigned long long* o8 = (unsigned long long*)(H + row * D) + lane;
#pragma unroll
            for (int j = 0; j < 4; ++j) { const f32x4 h = v[j] * rstd * gs[j] + sh[j]; o8[64 * j] = (unsigned long long)pk2(h[0], h[1]) | ((unsigned long long)pk2(h[2], h[3]) << 32); } }
    }
}

__device__ __forceinline__ void p_elem(const Args& a, int chunk) {
    const bf16_t* Z = (const bf16_t*)(a.ws + WS_Z);
    bf16_t* Y = (bf16_t*)(a.ws + WS_Y); bf16_t* R = (bf16_t*)(a.ws + WS_R); bf16_t* SB = (bf16_t*)(a.ws + WS_SB);
    const size_t nthr = (size_t)gridDim.x * NTHREADS;
    int tid2 = threadIdx.x; asm volatile("" : "+v"(tid2));
    for (size_t idx = (size_t)blockIdx.x * NTHREADS + tid2; idx < (size_t)CH_TOK * D; idx += nthr) {
        const int tl = (int)(idx >> 10), c = (int)(idx & 1023); const size_t t = (size_t)chunk * CH_TOK + tl; const int s = (int)(t & (SEQ - 1));
        const bf16_t* zr = Z + (size_t)tl * INW;
        const int Lav = 256 * (c >> 7) + (c & 127); const int w = 2 << (c >> 8); const int cnt = (s + 1) < w ? (s + 1) : w;
        float sum = 0.f; for (int j = 0; j < cnt; ++j) sum += bf2f(zr[(ptrdiff_t)Lav - (ptrdiff_t)j * INW]);
        const float pooled = sum / (float)cnt - bf2f(zr[Lav]);
        const float ya = a.pool_scale[c] * pooled * silu_f(bf2f(zr[Lav + 128]));
        const int q = c >> 6, wcv = (c >> 4) & 3, i = c & 15, wi = ((i >> 2) << 3) | (i & 3), base = 256 * (8 + q) + 32 * wcv + wi;
        const float u0 = bf2f(zr[base]) * bf2f(zr[base + 4]);
        const float u1 = s >= 1 ? bf2f(zr[base - INW]) * bf2f(zr[base + 4 - INW]) : 0.f;
        const float u2 = s >= 2 ? bf2f(zr[base - 2 * INW]) * bf2f(zr[base + 4 - 2 * INW]) : 0.f;
        const float conv = a.conv_b[c] + a.conv_w[c] * u2 + a.conv_w[D + c] * u1 + a.conv_w[2 * D + c] * u0;
        const float yb = bf2f(zr[base + 128]) * conv * silu_f(bf2f(zr[base + 132]));
        const int Lma = 256 * (24 + (c >> 7)) + (c & 127);
        const float ea = __expf(-bf2f(zr[Lma])), eb = __expf(-bf2f(zr[Lma + 128]));
        const float sb = 1.f / (1.f + eb), r = (1.f + eb) / (1.f + ea);
        Y[t * 2048 + c] = (bf16_t)f2bf(ya); Y[t * 2048 + D + c] = (bf16_t)f2bf(yb); R[t * D + c] = (bf16_t)f2bf(r); SB[t * D + c] = (bf16_t)f2bf(sb);
    }
}

__device__ __forceinline__ void p5_final(const Args& a) {
    const int tid = threadIdx.x, lane = tid & 63, wave = tid >> 6;
    const int gw = blockIdx.x * NWAVES + wave, NGW = gridDim.x * NWAVES;
    const float* part = (const float*)(a.ws + WS_PART);
    f32x4 fg[4];
#pragma unroll
    for (int j = 0; j < 4; ++j) fg[j] = *(const f32x4*)(a.final_g + 4 * lane + 256 * j);
    for (int row = gw; row < T; row += NGW) {
        float s = part[(size_t)row * 16 + (lane & 15)];
        s += __shfl_xor(s, 1); s += __shfl_xor(s, 2); s += __shfl_xor(s, 4); s += __shfl_xor(s, 8);
        const float rstd = rsqrtf(s * (1.f / D) + EPS);
        f32x4* o = (f32x4*)(a.out + (size_t)row * D) + lane;
#pragma unroll
        for (int j = 0; j < 4; ++j) o[64 * j] = o[64 * j] * rstd * fg[j];
    }
}

__global__ void __launch_bounds__(NTHREADS, 2) mega_fwd(Args a) {
    extern __shared__ __attribute__((aligned(16))) unsigned char lds_raw[];
    LAS unsigned char* lds = (LAS unsigned char*)lds_raw;
    cg::grid_group grid = cg::this_grid();
    const int G = gridDim.x;
    p0_prep(lds, a);
    grid.sync();
    p1_h(a);
    grid.sync();
    for (int ch = 0; ch < NCHUNK; ++ch) {
        { pg8::Gemm g{(const bf16_t*)(a.ws + WS_H) + (size_t)ch * CH_TOK * D, (const bf16_t*)(a.ws + WS_W1T), CH_TOK, INW, D};
          pg8::StaticOrder S; S.init(CH_TOK, INW, G, (int)blockIdx.x);
          pg8::EpiZ E{(bf16_t*)(a.ws + WS_Z), INW, (const float*)(a.ws + WS_BIAS1)};
          pg8::gemm_phase<pg8::EpiZ, pg8::StaticOrder>(lds, g, S, E); }
        grid.sync();
        p_elem(a, ch);
        grid.sync();
    }
    { pg8::Gemm g{(const bf16_t*)(a.ws + WS_Y), (const bf16_t*)(a.ws + WS_WABT), T, D, 2 * D};
      pg8::StaticOrder S; S.init(T, D, G, (int)blockIdx.x);
      pg8::EpiMerge E{(const bf16_t*)(a.ws + WS_R), (const bf16_t*)(a.ws + WS_SB), (bf16_t*)(a.ws + WS_H)};
      pg8::gemm_phase<pg8::EpiMerge, pg8::StaticOrder>(lds, g, S, E); }
    grid.sync();
    { pg8::Gemm g{(const bf16_t*)(a.ws + WS_H), (const bf16_t*)(a.ws + WS_WOT), T, D, D};
      pg8::StaticOrder S; S.init(T, D, G, (int)blockIdx.x);
      pg8::EpiXnew E{a.x, (const float*)(a.ws + WS_GATE), a.out, (float*)(a.ws + WS_PART)};
      pg8::gemm_phase<pg8::EpiXnew, pg8::StaticOrder>(lds, g, S, E); }
    grid.sync();
    p5_final(a);
}
}

extern "C" void kernel_launch(void* const* d_in, const int* in_sizes, int n_in, void* d_out, int out_size, void* d_ws, size_t ws_size, hipStream_t stream) {
    static int grid = 0;
    if (grid == 0) {
        if (n_in != 15 || out_size != T * D || ws_size < WS_END) { fprintf(stderr, "kernel_launch: unexpected shapes (n_in %d out %d ws %zu)\n", n_in, out_size, ws_size); grid = -1; return; }
        int dev = 0, cus = 0, per_cu = 0;
        hipGetDevice(&dev); hipDeviceGetAttribute(&cus, hipDeviceAttributeMultiprocessorCount, dev);
        if (hipFuncSetAttribute((const void*)mega_fwd, hipFuncAttributeMaxDynamicSharedMemorySize, LDS_BYTES) != hipSuccess) { fprintf(stderr, "kernel_launch: hipFuncSetAttribute failed\n"); grid = -1; return; }
        if (hipOccupancyMaxActiveBlocksPerMultiprocessor(&per_cu, (const void*)mega_fwd, NTHREADS, LDS_BYTES) != hipSuccess || per_cu < 1) { fprintf(stderr, "kernel_launch: occupancy query failed (%d)\n", per_cu); (void)hipGetLastError(); per_cu = 1; }
        grid = cus * 1;
        fprintf(stderr, "kernel_launch: %d CUs, occupancy %d/CU, grid %d\n", cus, per_cu, grid);
    }
    if (grid < 0) return;
    Args a{};
    a.x = (const float*)d_in[0]; a.c = (const float*)d_in[1]; a.ada_w = (const float*)d_in[2]; a.ada_b = (const float*)d_in[3]; a.norm_g = (const float*)d_in[4];
    a.w_in = (const float*)d_in[5]; a.b_in = (const float*)d_in[6]; a.pool_w = (const float*)d_in[7]; a.pool_scale = (const float*)d_in[8]; a.conv_w = (const float*)d_in[9];
    a.conv_b = (const float*)d_in[10]; a.w_out_a = (const float*)d_in[11]; a.w_out_b = (const float*)d_in[12]; a.w_o = (const float*)d_in[13]; a.final_g = (const float*)d_in[14];
    a.out = (float*)d_out; a.ws = (unsigned char*)d_ws;
    void* args[] = {&a};
    hipError_t e = hipLaunchCooperativeKernel((const void*)mega_fwd, dim3(grid), dim3(NTHREADS), args, LDS_BYTES, stream);
    if (e != hipSuccess) fprintf(stderr, "kernel_launch: cooperative launch failed: %s (grid %d)\n", hipGetErrorString(e), grid);
}
```

```cpp
#include <hip/hip_runtime.h>
#include <hip/hip_cooperative_groups.h>
#include <cstdio>
#include <cstdint>
namespace cg = cooperative_groups;

#define LAS __attribute__((address_space(3)))
typedef unsigned short bf16_t;
typedef short bf16x8 __attribute__((ext_vector_type(8)));
typedef float f32x4 __attribute__((ext_vector_type(4)));
typedef unsigned u32x4 __attribute__((ext_vector_type(4)));

namespace {
constexpr int D = 1024, NB = 32, SEQ = 2048, T = NB * SEQ, INW = 8192;
constexpr float EPS = 1e-6f;
constexpr int NWAVES = 8, NTHREADS = 512;
constexpr size_t MiB = 1u << 20;
constexpr size_t WS_MODP = 0;
constexpr size_t WS_GATE = 3 * MiB;
constexpr size_t WS_BIAS1 = WS_GATE + 131072;
constexpr size_t WS_PART = 4 * MiB;
constexpr size_t WS_W1T = 8 * MiB;
constexpr size_t WS_WABT = 24 * MiB;
constexpr size_t WS_WOT = 28 * MiB;
constexpr size_t WS_H = 32 * MiB;
constexpr size_t WS_Y = 160 * MiB;
constexpr size_t WS_R = 416 * MiB;
constexpr size_t WS_SB = 544 * MiB;
constexpr size_t WS_END = 672 * MiB;
constexpr int XCH_OFF = 131072;
constexpr int HALO_OFF = XCH_OFF + 3 * 4 * 64 * 16;
constexpr int LDS_BYTES = HALO_OFF + 2 * 4 * 64 * 16;

__device__ __forceinline__ unsigned f2bf(float f) { unsigned u = __builtin_bit_cast(unsigned, f); return (u + 0x7fffu + ((u >> 16) & 1u)) >> 16; }
__device__ __forceinline__ unsigned pk2(float lo, float hi) { return f2bf(lo) | (f2bf(hi) << 16); }
__device__ __forceinline__ float bf2f(bf16_t b) { return __builtin_bit_cast(float, (unsigned)b << 16); }
__device__ __forceinline__ float bflo(unsigned w) { return __builtin_bit_cast(float, w << 16); }
__device__ __forceinline__ float bfhi(unsigned w) { return __builtin_bit_cast(float, w & 0xffff0000u); }
typedef __bf16 bf16x2_t __attribute__((ext_vector_type(2)));
typedef float f32x2_t __attribute__((ext_vector_type(2)));
__device__ __forceinline__ unsigned cvt_pk_bf16(float lo, float hi) { const f32x2_t f = {lo, hi}; const bf16x2_t v = __builtin_convertvector(f, bf16x2_t); return __builtin_bit_cast(unsigned, v); }
__device__ __forceinline__ float silu_f(float v) { return v / (1.f + __expf(-v)); }
#define LDS_WAIT() asm volatile("s_waitcnt lgkmcnt(0)" ::: "memory")

__device__ __forceinline__ int src_col(int L) {
    const int pn = L >> 8, lc = L & 255;
    if (pn < 8) return lc < 128 ? -(1 + pn * 128 + lc) : 1024 + pn * 128 + (lc - 128);
    if (pn < 24) { const int q = pn - 8, half = lc >> 7, wc = (lc >> 5) & 3, n = (lc >> 2) & 1, i = (((lc >> 3) & 3) << 2) | (lc & 3);
        const int ch = q * 64 + wc * 16 + i; const int seg = half ? (n ? 5120 : 2048) : (n ? 4096 : 3072); return seg + ch; }
    const int q = pn - 24; return lc < 128 ? 6144 + q * 128 + lc : 7168 + q * 128 + (lc - 128);
}

namespace pg8 {
constexpr int BM = 256, BK = 64, HALF = 128, HTB = HALF * BK * 2, STAGE_BYTES = 8 * HTB, NXCD = 8, WGM = 8;
__device__ __forceinline__ int lds_byte(int r, int c) { const int st = (r >> 4) * 2 + (c >> 5), rr = r & 15, cc = c & 31, ob = rr * 64 + cc * 2; return st * 1024 + (ob ^ (((ob >> 9) & 1) << 5)); }
__device__ __forceinline__ void stage_rc(int b, int& R, int& C) { const int st = b / 1024, sb = b % 1024, swz = sb ^ (((sb >> 9) & 1) << 5); R = (st >> 1) * 16 + swz / 64; C = (st & 1) * 32 + (swz % 64) / 2; }
__device__ __forceinline__ int perm32(int rho) { const int n = rho >> 4, i = rho & 15; return 8 * (i >> 2) + 4 * n + (i & 3); }
struct Unit { int pm, pn; };
struct Gemm { const bf16_t* A; const bf16_t* Bt; int M, N, K; };
struct StaticOrder {
    int nM, nN, nwg, G, c;
    __device__ void init(int M, int N, int G_, int c_) { nM = M / BM; nN = N / BM; nwg = nM * nN; G = G_; c = c_; }
    __device__ bool next(int i, Unit& u) const {
        const long L = (long)i * G + c; if (L >= nwg) return false;
        int wgid = (int)L; { const int q = nwg / NXCD, r = nwg % NXCD, xcd = wgid % NXCD, off = wgid / NXCD; wgid = (xcd < r ? xcd * (q + 1) : r * (q + 1) + (xcd - r) * q) + off; }
        const int nig = WGM * nN, gid = wgid / nig, fm = gid * WGM, gsz = (nM - fm) < WGM ? (nM - fm) : WGM;
        u.pm = fm + ((wgid % nig) % gsz); u.pn = (wgid % nig) / gsz; return true;
    }
};

struct StripOrder {
    int c;
    __device__ bool next(int i, Unit& u) const {
        if (i >= 32) return false;
        const int rho = i >> 3, tt = i & 7, x = c & 7, j = c >> 3, bg = x >> 1, ph = x & 1, b = 8 * bg + (j & 7), pnq = j >> 3;
        u.pn = rho == 0 ? 4 * ph + pnq : (rho == 3 ? 24 + 4 * ph + pnq : 8 + 8 * ph + 4 * (rho - 1) + pnq);
        u.pm = b * 8 + tt; return true;
    }
};
__device__ __forceinline__ bf16x8 mk_frag(unsigned a, unsigned b, unsigned c, unsigned d) { const u32x4 t = {a, b, c, d}; return __builtin_bit_cast(bf16x8, t); }
__device__ __forceinline__ bf16x8 pool_frag(int fr, int fq, int w, bool first) {
    float v[8];
#pragma unroll
    for (int j = 0; j < 8; ++j) { const int sx = j < 4 ? -16 + 4 * fq + j : 4 * fq + j - 4, d = fr - sx; const int cnt = first ? ((fr + 1) < w ? (fr + 1) : w) : w;
        v[j] = d == 0 ? (float)(1 - cnt) : ((d > 0 && d < w) ? 1.f : 0.f); }
    return mk_frag(pk2(v[0], v[1]), pk2(v[2], v[3]), pk2(v[4], v[5]), pk2(v[6], v[7]));
}
__device__ __forceinline__ bf16x8 shift_frag(int fr, int fq, int sh) {
    float v[8];
#pragma unroll
    for (int j = 0; j < 8; ++j) { const int sx = j < 4 ? -16 + 4 * fq + j : 4 * fq + j - 4; v[j] = (fr - sx == sh) ? 1.f : 0.f; }
    return mk_frag(pk2(v[0], v[1]), pk2(v[2], v[3]), pk2(v[4], v[5]), pk2(v[6], v[7]));
}
__device__ __forceinline__ float rcp_f(float v) { return __builtin_amdgcn_rcpf(v); }
__device__ __forceinline__ f32x4 silu4(f32x4 v) { f32x4 o;
#pragma unroll
    for (int r = 0; r < 4; ++r) o[r] = v[r] * rcp_f(1.f + __expf(-v[r]));
    return o; }
struct EpiMix {
    static constexpr bool PERM = true, MID = false;
    const float* bias1; const float* pool_scale; const float* conv_w; const float* conv_b; bf16_t* Y; bf16_t* R; bf16_t* SB;
    __device__ __forceinline__ void mid(f32x4 (&)[2][2][4][2], const Unit&, int, int, int, int) const {}
    __device__ __forceinline__ void operator()(f32x4 (&acc)[2][2][4][2], const Unit& u, int wr, int wc, int fr, int fq, LAS unsigned char* lds, int lane) const {
        const int pn = u.pn, tt = u.pm & 7, par = tt & 1;
        const f32x4 zero4 = {0.f, 0.f, 0.f, 0.f};
        const size_t row0 = (size_t)u.pm * BM + wr * 64 + fr;
        const float* bl = bias1 + pn * 256;
        LAS unsigned char* xch = lds + XCH_OFF + (wc * 64 + lane) * 16;
        LAS unsigned char* halo = lds + HALO_OFF + (wc * 64 + lane) * 16;
        if (pn < 8) {
            const int w = 2 << (pn >> 1);
            const int cb = 32 * wc + 8 * fq;
            const f32x4 g0 = *(const f32x4*)(pool_scale + pn * 128 + cb), g1 = *(const f32x4*)(pool_scale + pn * 128 + cb + 4);
            const f32x4 ba0 = *(const f32x4*)(bl + 128 + cb), ba1 = *(const f32x4*)(bl + 128 + cb + 4);
#pragma unroll
            for (int ai = 0; ai < 2; ++ai) { const f32x4 a0 = acc[ai][0][3][0], a1 = acc[ai][0][3][1];
                const u32x4 p = {cvt_pk_bf16(a0[0], a0[1]), cvt_pk_bf16(a0[2], a0[3]), cvt_pk_bf16(a1[0], a1[1]), cvt_pk_bf16(a1[2], a1[3])};
                const int slab = 2 * ai + wr; *(LAS u32x4*)(slab == 3 ? halo + par * 4096 : xch + slab * 4096) = p; }
            LDS_WAIT(); __builtin_amdgcn_s_barrier(); asm volatile("" ::: "memory");
            const bf16x8 Mg = pool_frag(fr, fq, w, false);
            const float icg = 1.f / (float)w;
#pragma unroll
            for (int ai = 0; ai < 2; ++ai) { const int slab = 2 * ai + wr;
                u32x4 pv = {0u, 0u, 0u, 0u};
                if (slab > 0) pv = *(const LAS u32x4*)(xch + (slab - 1) * 4096); else if (tt != 0) pv = *(const LAS u32x4*)(halo + (par ^ 1) * 4096);
                unsigned p0x = pv.x, p0y = pv.y, p1x = pv.z, p1y = pv.w;
#pragma unroll
                for (int m = 0; m < 4; ++m) {
                    const bool fst = (tt == 0) && (slab == 0) && (m == 0);
                    bf16x8 Mf = Mg; float ic = icg;
                    if (fst) { Mf = pool_frag(fr, fq, w, true); ic = 1.f / (float)((fr + 1) < w ? (fr + 1) : w); }
                    const f32x4 a0 = acc[ai][0][m][0], a1 = acc[ai][0][m][1];
                    const unsigned c0x = cvt_pk_bf16(a0[0], a0[1]), c0y = cvt_pk_bf16(a0[2], a0[3]), c1x = cvt_pk_bf16(a1[0], a1[1]), c1y = cvt_pk_bf16(a1[2], a1[3]);
                    const f32x4 d0 = __builtin_amdgcn_mfma_f32_16x16x32_bf16(mk_frag(p0x, p0y, c0x, c0y), Mf, zero4, 0, 0, 0);
                    const f32x4 d1 = __builtin_amdgcn_mfma_f32_16x16x32_bf16(mk_frag(p1x, p1y, c1x, c1y), Mf, zero4, 0, 0, 0);
                    p0x = c0x; p0y = c0y; p1x = c1x; p1y = c1y;
                    const f32x4 v0 = g0 * (d0 * ic) * silu4(acc[ai][1][m][0] + ba0), v1 = g1 * (d1 * ic) * silu4(acc[ai][1][m][1] + ba1);
                    u32x4 o; o.x = cvt_pk_bf16(v0[0], v0[1]); o.y = cvt_pk_bf16(v0[2], v0[3]); o.z = cvt_pk_bf16(v1[0], v1[1]); o.w = cvt_pk_bf16(v1[2], v1[3]);
                    *(u32x4*)(Y + (row0 + ai * HALF + m * 16) * 2048 + pn * 128 + cb) = o; } }
        } else if (pn < 24) {
            const int q = pn - 8;
            const int lcn = 32 * wc + 8 * (fr >> 2) + (fr & 3);
            const float bC = bl[lcn], bv = bl[lcn + 4];
            const int cb4 = 16 * wc + 4 * fq;
            const f32x4 bB = *(const f32x4*)(bl + 128 + 32 * wc + 8 * fq), bg = *(const f32x4*)(bl + 128 + 32 * wc + 8 * fq + 4);
            const f32x4 k0 = *(const f32x4*)(conv_w + q * 64 + cb4), k1 = *(const f32x4*)(conv_w + D + q * 64 + cb4), k2 = *(const f32x4*)(conv_w + 2 * D + q * 64 + cb4), kb = *(const f32x4*)(conv_b + q * 64 + cb4);
#pragma unroll
            for (int ai = 0; ai < 2; ++ai) { const f32x4 uu = (acc[ai][0][3][0] + bC) * (acc[ai][0][3][1] + bv);
                const u32x4 p = {cvt_pk_bf16(uu[0], uu[1]), cvt_pk_bf16(uu[2], uu[3]), 0u, 0u};
                const int slab = 2 * ai + wr; *(LAS u32x4*)(slab == 3 ? halo + par * 4096 : xch + slab * 4096) = p; }
            LDS_WAIT(); __builtin_amdgcn_s_barrier(); asm volatile("" ::: "memory");
            const bf16x8 S0 = shift_frag(fr, fq, 0), S1 = shift_frag(fr, fq, 1), S2 = shift_frag(fr, fq, 2);
#pragma unroll
            for (int ai = 0; ai < 2; ++ai) { const int slab = 2 * ai + wr;
                u32x4 pv = {0u, 0u, 0u, 0u};
                if (slab > 0) pv = *(const LAS u32x4*)(xch + (slab - 1) * 4096); else if (tt != 0) pv = *(const LAS u32x4*)(halo + (par ^ 1) * 4096);
                unsigned px = pv.x, py = pv.y;
#pragma unroll
                for (int m = 0; m < 4; ++m) {
                    const f32x4 uu = (acc[ai][0][m][0] + bC) * (acc[ai][0][m][1] + bv);
                    const unsigned cx = cvt_pk_bf16(uu[0], uu[1]), cy = cvt_pk_bf16(uu[2], uu[3]);
                    const bf16x8 af = mk_frag(px, py, cx, cy); px = cx; py = cy;
                    const f32x4 d0 = __builtin_amdgcn_mfma_f32_16x16x32_bf16(af, S0, zero4, 0, 0, 0);
                    const f32x4 d1 = __builtin_amdgcn_mfma_f32_16x16x32_bf16(af, S1, zero4, 0, 0, 0);
                    const f32x4 d2 = __builtin_amdgcn_mfma_f32_16x16x32_bf16(af, S2, zero4, 0, 0, 0);
                    const f32x4 conv = kb + k2 * d0 + k1 * d1 + k0 * d2;
                    const f32x4 v = (acc[ai][1][m][0] + bB) * conv * silu4(acc[ai][1][m][1] + bg);
                    uint2 o; o.x = cvt_pk_bf16(v[0], v[1]); o.y = cvt_pk_bf16(v[2], v[3]);
                    *(uint2*)(Y + (row0 + ai * HALF + m * 16) * 2048 + D + q * 64 + cb4) = o; } }
        } else {
            const int q = pn - 24;
            const int lcn = 32 * wc + 8 * (fr >> 2) + (fr & 3);
            const float bm0 = bl[lcn], bm1 = bl[lcn + 4];
            const int cb = 32 * wc + 8 * fq;
            const f32x4 bb0 = *(const f32x4*)(bl + 128 + cb), bb1 = *(const f32x4*)(bl + 128 + cb + 4);
            const bf16x8 S0 = shift_frag(fr, fq, 0);
#pragma unroll
            for (int ai = 0; ai < 2; ++ai)
#pragma unroll
                for (int m = 0; m < 4; ++m) {
                    f32x4 sa0, sa1;
#pragma unroll
                    for (int r = 0; r < 4; ++r) { sa0[r] = rcp_f(1.f + __expf(-(acc[ai][0][m][0][r] + bm0))); sa1[r] = rcp_f(1.f + __expf(-(acc[ai][0][m][1][r] + bm1))); }
                    const f32x4 t0 = __builtin_amdgcn_mfma_f32_16x16x32_bf16(mk_frag(0u, 0u, cvt_pk_bf16(sa0[0], sa0[1]), cvt_pk_bf16(sa0[2], sa0[3])), S0, zero4, 0, 0, 0);
                    const f32x4 t1 = __builtin_amdgcn_mfma_f32_16x16x32_bf16(mk_frag(0u, 0u, cvt_pk_bf16(sa1[0], sa1[1]), cvt_pk_bf16(sa1[2], sa1[3])), S0, zero4, 0, 0, 0);
                    f32x4 r0, r1, s0, s1;
#pragma unroll
                    for (int r = 0; r < 4; ++r) { const float e0 = __expf(-(acc[ai][1][m][0][r] + bb0[r])), e1 = __expf(-(acc[ai][1][m][1][r] + bb1[r]));
                        r0[r] = t0[r] * (1.f + e0); r1[r] = t1[r] * (1.f + e1); s0[r] = rcp_f(1.f + e0); s1[r] = rcp_f(1.f + e1); }
                    const size_t off = (row0 + ai * HALF + m * 16) * D + q * 128 + cb;
                    u32x4 o; o.x = cvt_pk_bf16(r0[0], r0[1]); o.y = cvt_pk_bf16(r0[2], r0[3]); o.z = cvt_pk_bf16(r1[0], r1[1]); o.w = cvt_pk_bf16(r1[2], r1[3]);
                    *(u32x4*)(R + off) = o;
                    o.x = cvt_pk_bf16(s0[0], s0[1]); o.y = cvt_pk_bf16(s0[2], s0[3]); o.z = cvt_pk_bf16(s1[0], s1[1]); o.w = cvt_pk_bf16(s1[2], s1[3]);
                    *(u32x4*)(SB + off) = o; }
        }
    }
};
struct EpiMerge {
    static constexpr bool PERM = true, MID = true;
    const bf16_t* R; const bf16_t* SB; bf16_t* O;
    __device__ __forceinline__ void mid(f32x4 (&acc)[2][2][4][2], const Unit& u, int wr, int wc, int fr, int fq) const {
        const int row0 = u.pm * BM + wr * 64 + fr, col0 = u.pn * BM + wc * 32 + 8 * fq;
#pragma unroll
        for (int ai = 0; ai < 2; ++ai)
#pragma unroll
            for (int m = 0; m < 4; ++m) { const bf16_t* rp = R + (size_t)(row0 + ai * HALF + m * 16) * D + col0;
#pragma unroll
                for (int bj = 0; bj < 2; ++bj) { const u32x4 w = *(const u32x4*)(rp + bj * HALF);
                    acc[ai][bj][m][0] *= (f32x4){bflo(w.x), bfhi(w.x), bflo(w.y), bfhi(w.y)};
                    acc[ai][bj][m][1] *= (f32x4){bflo(w.z), bfhi(w.z), bflo(w.w), bfhi(w.w)}; } }
    }
    __device__ __forceinline__ void operator()(f32x4 (&acc)[2][2][4][2], const Unit& u, int wr, int wc, int fr, int fq, LAS unsigned char*, int) const {
        const int row0 = u.pm * BM + wr * 64 + fr, col0 = u.pn * BM + wc * 32 + 8 * fq;
#pragma unroll
        for (int ai = 0; ai < 2; ++ai)
#pragma unroll
            for (int m = 0; m < 4; ++m) { const size_t off = (size_t)(row0 + ai * HALF + m * 16) * D + col0;
#pragma unroll
                for (int bj = 0; bj < 2; ++bj) { const u32x4 s = *(const u32x4*)(SB + off + bj * HALF);
                    const f32x4 v0 = acc[ai][bj][m][0] * (f32x4){bflo(s.x), bfhi(s.x), bflo(s.y), bfhi(s.y)};
                    const f32x4 v1 = acc[ai][bj][m][1] * (f32x4){bflo(s.z), bfhi(s.z), bflo(s.w), bfhi(s.w)};
                    u32x4 w; w.x = cvt_pk_bf16(v0[0], v0[1]); w.y = cvt_pk_bf16(v0[2], v0[3]); w.z = cvt_pk_bf16(v1[0], v1[1]); w.w = cvt_pk_bf16(v1[2], v1[3]);
                    *(u32x4*)(O + off + bj * HALF) = w; } }
    }
};
struct EpiXnew {
    static constexpr bool PERM = false, MID = false;
    const float* x; const float* gate; float* out; float* part;
    __device__ __forceinline__ void mid(f32x4 (&)[2][2][4][2], const Unit&, int, int, int, int) const {}
    __device__ __forceinline__ void operator()(f32x4 (&acc)[2][2][4][2], const Unit& u, int wr, int wc, int fr, int fq, LAS unsigned char*, int) const {
        const int row0 = u.pm * BM + wr * 64 + fr, col0 = u.pn * BM + wc * 32 + 4 * fq; const int b = u.pm >> 3;
        f32x4 gv[2][2];
#pragma unroll
        for (int bj = 0; bj < 2; ++bj)
#pragma unroll
            for (int n = 0; n < 2; ++n) gv[bj][n] = *(const f32x4*)(gate + b * D + col0 + bj * HALF + n * 16);
#pragma unroll
        for (int ai = 0; ai < 2; ++ai)
#pragma unroll
            for (int m = 0; m < 4; ++m) { const int row = row0 + ai * HALF + m * 16; const size_t off = (size_t)row * D + col0; float s = 0.f;
#pragma unroll
                for (int bj = 0; bj < 2; ++bj)
#pragma unroll
                    for (int n = 0; n < 2; ++n) { const f32x4 xv = *(const f32x4*)(x + off + bj * HALF + n * 16); const f32x4 o = xv + gv[bj][n] * acc[ai][bj][m][n];
                        *(f32x4*)(out + off + bj * HALF + n * 16) = o; s += (o[0] * o[0] + o[1] * o[1]) + (o[2] * o[2] + o[3] * o[3]); }
                s += __shfl_xor(s, 16); s += __shfl_xor(s, 32);
                if (fq == 0) part[(size_t)row * 16 + u.pn * 4 + wc] = s;
                asm volatile("" ::: "memory"); }
    }
};

template <class Epi, class Sched, bool MIXED = false, bool ALIGN_EPI = true, bool SP2 = true>
__device__ __forceinline__ void gemm_phase(LAS unsigned char* lds, const Gemm g, const Sched& S, const Epi& E) {
    const int tid = threadIdx.x, wid = __builtin_amdgcn_readfirstlane(tid >> 6), lane = tid & 63, wr = wid >> 2, wc = wid & 3, fr = lane & 15, fq = lane >> 4;
    const int K = g.K, nt = K / BK;
    unsigned voffA[2], voffB[2];
#pragma unroll
    for (int i = 0; i < 2; ++i) { int R, C; stage_rc(tid * 16 + i * 8192, R, C); const int Rb = Epi::PERM ? ((R & ~31) + perm32(R & 31)) : R;
        voffA[i] = (unsigned)(R * K + C) * 2u; voffB[i] = (unsigned)(Rb * K + C) * 2u; }
    const size_t kstep = (size_t)(BK * 2);
    const size_t hstep = (size_t)HALF * K * 2;
    const size_t tstep = 2 * hstep;
    const unsigned ldsw = (unsigned)wid * 1024u;
    const int aoff = lds_byte(wr * 64 + fr, fq * 8), boff = lds_byte(wc * 32 + fr, fq * 8);
#define PG8_SA(b, h) (((b) * 2 + (h)) * HTB)
#define PG8_SB(b, h) ((4 + (b) * 2 + (h)) * HTB)
#define PG8_STAGE(bufoff, gbase, voff) do { _Pragma("unroll") for (int _i = 0; _i < 2; ++_i) \
        __builtin_amdgcn_global_load_lds((const unsigned*)((const char*)(gbase) + (voff)[_i]), (LAS unsigned*)(lds + (bufoff) + ldsw + _i * 8192), 16, 0, 0); } while (0)
#define PG8_LDA(dst, b, h) do { _Pragma("unroll") for (int m = 0; m < 4; ++m) _Pragma("unroll") for (int k = 0; k < 2; ++k) dst[m][k] = *(const LAS bf16x8*)(lds + PG8_SA(b, h) + aoff + m * 2048 + k * 1024); } while (0)
#define PG8_LDB(dst, b, h) do { _Pragma("unroll") for (int n = 0; n < 2; ++n) _Pragma("unroll") for (int k = 0; k < 2; ++k) dst[n][k] = *(const LAS bf16x8*)(lds + PG8_SB(b, h) + boff + n * 2048 + k * 1024); } while (0)
#define PG8_MMA(ai, bj, At, Bt) do { __builtin_amdgcn_s_setprio(1); _Pragma("unroll") for (int m = 0; m < 4; ++m) _Pragma("unroll") for (int n = 0; n < 2; ++n) _Pragma("unroll") for (int k = 0; k < 2; ++k) \
        { if constexpr (MIXED && (bj) == 0) acc[ai][bj][m][n] = __builtin_amdgcn_mfma_f32_16x16x32_bf16(At[m][k], Bt[n][k], acc[ai][bj][m][n], 0, 0, 0); \
          else acc[ai][bj][m][n] = __builtin_amdgcn_mfma_f32_16x16x32_bf16(Bt[n][k], At[m][k], acc[ai][bj][m][n], 0, 0, 0); } __builtin_amdgcn_s_setprio(0); } while (0)
#define PG8_WAIT_V(n) asm volatile("s_waitcnt vmcnt(" #n ")" ::: "memory")
#define PG8_WAIT_L(n) asm volatile("s_waitcnt lgkmcnt(" #n ")" ::: "memory")
#define PG8_BAR __builtin_amdgcn_s_barrier()
#define PG8_SCHED __builtin_amdgcn_sched_barrier(0)
    Unit cur, nxt; int ui = 0;
    if (!S.next(0, cur)) return;
    f32x4 acc[2][2][4][2];
#pragma unroll
    for (int a = 0; a < 2; ++a)
#pragma unroll
        for (int b = 0; b < 2; ++b)
#pragma unroll
            for (int m = 0; m < 4; ++m)
#pragma unroll
                for (int n = 0; n < 2; ++n) acc[a][b][m][n] = (f32x4){0.f, 0.f, 0.f, 0.f};
    bf16x8 At[4][2], B0[2][2], B1[2][2];
    const char* cA = (const char*)g.A + (size_t)cur.pm * tstep; const char* cB = (const char*)g.Bt + (size_t)cur.pn * tstep;
    if constexpr (SP2) {
        PG8_STAGE(PG8_SB(0, 0), cB, voffB); PG8_STAGE(PG8_SB(0, 1), cB + hstep, voffB); PG8_STAGE(PG8_SA(0, 0), cA, voffA); PG8_STAGE(PG8_SA(0, 1), cA + hstep, voffA);
        if (wr == 1) PG8_BAR;
        PG8_WAIT_V(2); PG8_BAR;
        PG8_STAGE(PG8_SB(1, 0), cB + kstep, voffB); PG8_STAGE(PG8_SA(1, 0), cA + kstep, voffA); PG8_STAGE(PG8_SB(1, 1), cB + hstep + kstep, voffB);
        PG8_WAIT_V(6); PG8_BAR;
    } else {
        PG8_STAGE(PG8_SB(0, 0), cB, voffB); PG8_STAGE(PG8_SA(0, 0), cA, voffA); PG8_STAGE(PG8_SB(0, 1), cB + hstep, voffB); PG8_STAGE(PG8_SA(0, 1), cA + hstep, voffA);
        if (wr == 1) PG8_BAR;
        PG8_WAIT_V(4); PG8_BAR;
        PG8_STAGE(PG8_SB(1, 0), cB + kstep, voffB); PG8_STAGE(PG8_SA(1, 0), cA + kstep, voffA); PG8_STAGE(PG8_SB(1, 1), cB + hstep + kstep, voffB);
        PG8_WAIT_V(6); PG8_BAR;
    }
    for (;;) {
        const bool has_next = S.next(ui + 1, nxt);
        const char* nA = has_next ? (const char*)g.A + (size_t)nxt.pm * tstep : cA; const char* nB = has_next ? (const char*)g.Bt + (size_t)nxt.pn * tstep : cB;
        for (int t = 0; t < nt; t += 2) {
            const bool last = (t == nt - 2);
            const char* a1 = cA + (size_t)(t + 1) * kstep;
            const char* a2 = last ? nA : cA + (size_t)(t + 2) * kstep; const char* b2 = last ? nB : cB + (size_t)(t + 2) * kstep;
            const char* a3 = a2 + kstep; const char* b3 = b2 + kstep;
            if constexpr (Epi::MID) { if (t == (nt >> 1)) { int fr2 = fr, fq2 = fq; asm volatile("" : "+v"(fr2), "+v"(fq2)); E.mid(acc, cur, wr, wc, fr2, fq2); } }
            if constexpr (SP2) {
            PG8_LDB(B0, 0, 0); PG8_LDB(B1, 0, 1); PG8_SCHED; PG8_LDA(At, 0, 0); PG8_STAGE(PG8_SA(1, 1), a1 + hstep, voffA);
            PG8_WAIT_V(8); PG8_WAIT_L(0); PG8_BAR; PG8_MMA(0, 0, At, B0); PG8_MMA(0, 1, At, B1); PG8_BAR; PG8_SCHED;
            PG8_LDA(At, 0, 1); PG8_STAGE(PG8_SB(0, 0), b2, voffB); PG8_STAGE(PG8_SB(0, 1), b2 + hstep, voffB); PG8_STAGE(PG8_SA(0, 0), a2, voffA);
            PG8_WAIT_V(8); PG8_WAIT_L(0); PG8_BAR; PG8_MMA(1, 0, At, B0); PG8_MMA(1, 1, At, B1); PG8_BAR; PG8_SCHED;
            PG8_LDB(B0, 1, 0); PG8_LDB(B1, 1, 1); PG8_SCHED; PG8_LDA(At, 1, 0); PG8_STAGE(PG8_SA(0, 1), a2 + hstep, voffA);
            PG8_WAIT_V(8); PG8_WAIT_L(0); PG8_BAR; PG8_MMA(0, 0, At, B0); PG8_MMA(0, 1, At, B1); PG8_BAR; PG8_SCHED;
            PG8_LDA(At, 1, 1); PG8_STAGE(PG8_SB(1, 0), b3, voffB); PG8_STAGE(PG8_SB(1, 1), b3 + hstep, voffB); PG8_STAGE(PG8_SA(1, 0), a3, voffA);
            PG8_WAIT_V(8); PG8_WAIT_L(0); PG8_BAR; PG8_MMA(1, 0, At, B0); PG8_MMA(1, 1, At, B1); PG8_BAR; PG8_SCHED;
            } else {
            PG8_LDB(B0, 0, 0); PG8_SCHED; PG8_LDA(At, 0, 0); PG8_STAGE(PG8_SA(1, 1), a1 + hstep, voffA);
            PG8_WAIT_L(8); PG8_BAR; PG8_WAIT_L(0); PG8_MMA(0, 0, At, B0); PG8_BAR; PG8_SCHED;
            PG8_LDB(B1, 0, 1); PG8_STAGE(PG8_SB(0, 0), b2, voffB);
            PG8_BAR; PG8_WAIT_L(0); PG8_MMA(0, 1, At, B1); PG8_BAR;
            PG8_LDA(At, 0, 1); PG8_STAGE(PG8_SA(0, 0), a2, voffA);
            PG8_BAR; PG8_WAIT_L(0); PG8_MMA(1, 0, At, B0); PG8_BAR; PG8_SCHED;
            PG8_STAGE(PG8_SB(0, 1), b2 + hstep, voffB);
            PG8_WAIT_V(6); PG8_BAR; PG8_MMA(1, 1, At, B1); PG8_BAR;
            PG8_LDB(B0, 1, 0); PG8_SCHED; PG8_LDA(At, 1, 0); PG8_STAGE(PG8_SA(0, 1), a2 + hstep, voffA);
            PG8_WAIT_L(8); PG8_BAR; PG8_WAIT_L(0); PG8_MMA(0, 0, At, B0); PG8_BAR; PG8_SCHED;
            PG8_LDB(B1, 1, 1); PG8_STAGE(PG8_SB(1, 0), b3, voffB);
            PG8_BAR; PG8_WAIT_L(0); PG8_MMA(0, 1, At, B1); PG8_BAR;
            PG8_LDA(At, 1, 1); PG8_STAGE(PG8_SA(1, 0), a3, voffA);
            PG8_BAR; PG8_WAIT_L(0); PG8_MMA(1, 0, At, B0); PG8_BAR; PG8_SCHED;
            PG8_STAGE(PG8_SB(1, 1), b3 + hstep, voffB);
            PG8_WAIT_V(6); PG8_BAR; PG8_MMA(1, 1, At, B1); PG8_BAR;
            }
        }
        if constexpr (ALIGN_EPI) { if (wr == 0) PG8_BAR; }
        { int fr2 = fr, fq2 = fq; asm volatile("" : "+v"(fr2), "+v"(fq2)); E(acc, cur, wr, wc, fr2, fq2, lds, lane); }
        if (!has_next) break;
#pragma unroll
        for (int a = 0; a < 2; ++a)
#pragma unroll
            for (int b = 0; b < 2; ++b)
#pragma unroll
                for (int m = 0; m < 4; ++m)
#pragma unroll
                    for (int n = 0; n < 2; ++n) acc[a][b][m][n] = (f32x4){0.f, 0.f, 0.f, 0.f};
        cur = nxt; cA = nA; cB = nB; ++ui;
        if constexpr (ALIGN_EPI) { if (wr == 1) PG8_BAR; }
    }
    PG8_WAIT_V(0);
    if constexpr (!ALIGN_EPI) { if (wr == 0) PG8_BAR; }
    PG8_BAR;
#undef PG8_SA
#undef PG8_SB
#undef PG8_STAGE
#undef PG8_LDA
#undef PG8_LDB
#undef PG8_MMA
#undef PG8_WAIT_V
#undef PG8_WAIT_L
#undef PG8_BAR
#undef PG8_SCHED
}
}

struct Args {
    const float *x, *c, *ada_w, *ada_b, *norm_g, *w_in, *b_in, *pool_w, *pool_scale, *conv_w, *conv_b, *w_out_a, *w_out_b, *w_o, *final_g;
    float* out; unsigned char* ws;
};

__device__ __forceinline__ void p0_fold(LAS unsigned char* lds, const Args& a, int blk) {
    LAS float* wt = (LAS float*)lds;
    LAS float* pt = wt + 64 * 257;
    const int tid = threadIdx.x;
    const int k0 = (blk & 15) * 64, o0 = (blk >> 4) * 64, g = o0 >> 8, oo = o0 & 255;
    for (int j = 0; j < 32; ++j) { const int idx = tid + 512 * j, kk = idx >> 8, i = idx & 255; wt[kk * 257 + i] = a.w_in[(size_t)(k0 + kk) * INW + g * 256 + i]; }
    for (int j = 0; j < 32; ++j) { const int idx = tid + 512 * j, i = idx >> 6, cc = idx & 63; pt[i * 64 + cc] = a.pool_w[(size_t)g * 65536 + i * 256 + oo + cc]; }
    __syncthreads();
    const int kk = tid & 63, oq = tid >> 6;
    float acc[8];
#pragma unroll
    for (int j = 0; j < 8; ++j) acc[j] = 0.f;
    for (int i = 0; i < 256; ++i) { const float av = wt[kk * 257 + i]; const f32x4 p0 = *(const LAS f32x4*)(pt + i * 64 + oq * 8), p1 = *(const LAS f32x4*)(pt + i * 64 + oq * 8 + 4);
        acc[0] += av * p0[0]; acc[1] += av * p0[1]; acc[2] += av * p0[2]; acc[3] += av * p0[3]; acc[4] += av * p1[0]; acc[5] += av * p1[1]; acc[6] += av * p1[2]; acc[7] += av * p1[3]; }
    bf16_t* W1t = (bf16_t*)(a.ws + WS_W1T);
#pragma unroll
    for (int j = 0; j < 8; ++j) { const int o = o0 + oq * 8 + j; const int L = 256 * (o >> 7) + (o & 127); W1t[(size_t)L * D + k0 + kk] = (bf16_t)f2bf(acc[j]); }
    __syncthreads();
}
__device__ __forceinline__ void p0_tr_item(const float* W, int ldw, int sc, bf16_t* WT, int ldt, int koff, LAS float* scr, int k0, int n0, int lane) {
#pragma unroll 8
    for (int i = 0; i < 32; ++i) { const int kk = 2 * i + (lane >> 5); scr[kk * 33 + (lane & 31)] = W[(size_t)(k0 + kk) * ldw + sc]; }
    LDS_WAIT();
    const int c = lane & 7;
#pragma unroll
    for (int j = 0; j < 4; ++j) { const int n = (lane >> 3) + 8 * j; const LAS float* s = scr + (8 * c) * 33 + n;
        u32x4 o; o.x = pk2(s[0 * 33], s[1 * 33]); o.y = pk2(s[2 * 33], s[3 * 33]); o.z = pk2(s[4 * 33], s[5 * 33]); o.w = pk2(s[6 * 33], s[7 * 33]);
        *(u32x4*)(WT + (size_t)(n0 + n) * ldt + koff + k0 + 8 * c) = o; }
    LDS_WAIT();
}
__device__ __forceinline__ void p0_mod_item(const Args& a, LAS float* scr  , int jc, int kc, int lane) {
    for (int j = 0; j < 64; ++j) { const int idx = lane + 64 * j, kk = idx & 127, b = idx >> 7; scr[b * 128 + kk] = silu_f(a.c[b * D + kc * 128 + kk]); }
    LDS_WAIT();
    float acc[32];
#pragma unroll
    for (int b = 0; b < 32; ++b) acc[b] = 0.f;
    const float* wp = a.ada_w + (size_t)(kc * 128) * 3072 + jc * 64 + lane;
    for (int k4 = 0; k4 < 32; ++k4) {
        const float w0 = wp[(size_t)(k4 * 4 + 0) * 3072], w1 = wp[(size_t)(k4 * 4 + 1) * 3072], w2 = wp[(size_t)(k4 * 4 + 2) * 3072], w3 = wp[(size_t)(k4 * 4 + 3) * 3072];
#pragma unroll
        for (int b = 0; b < 32; ++b) { const f32x4 s = *(const LAS f32x4*)(scr + b * 128 + k4 * 4); acc[b] += (s[0] * w0 + s[1] * w1) + (s[2] * w2 + s[3] * w3); }
    }
    float* part = (float*)(a.ws + WS_MODP);
#pragma unroll
    for (int b = 0; b < 32; ++b) part[(size_t)(kc * 32 + b) * 3072 + jc * 64 + lane] = acc[b];
    LDS_WAIT();
}
__device__ __forceinline__ void p0_prep(LAS unsigned char* lds, const Args& a) {
    const int tid = threadIdx.x, lane = tid & 63, wave = __builtin_amdgcn_readfirstlane(tid >> 6);
    const int G = gridDim.x, gw = blockIdx.x * NWAVES + wave, NGW = G * NWAVES;
    { const int gid = blockIdx.x * NTHREADS + tid; if (gid < INW) { const int sc = src_col(gid); ((float*)(a.ws + WS_BIAS1))[gid] = sc < 0 ? 0.f : a.b_in[sc]; } }
    for (int it = blockIdx.x; it < 256; it += G) p0_fold(lds, a, it);
    LAS float* scr = (LAS float*)(lds + wave * 16384);
    bf16_t* W1t = (bf16_t*)(a.ws + WS_W1T); bf16_t* WABt = (bf16_t*)(a.ws + WS_WABT); bf16_t* Wot = (bf16_t*)(a.ws + WS_WOT);
    constexpr int I_1 = 16 * 256, I_A = 16 * 32, I_MOD = 48 * 8;
    for (int it = gw; it < I_MOD; it += NGW) p0_mod_item(a, scr, it % 48, it / 48, lane);
    for (int it = gw; it < I_1 + 3 * I_A; it += NGW) {
        int r = it;
        if (r < I_1) { const int kb = r & 15, nb = r >> 4; const int sc = src_col(nb * 32 + (lane & 31)); if (sc >= 0) p0_tr_item(a.w_in, INW, sc, W1t, D, 0, scr, kb * 64, nb * 32, lane); continue; } r -= I_1;
        const int kb = r & 15, nb = (r >> 4) & 31, which = r >> 9;
        if (which == 0) p0_tr_item(a.w_out_a, D, nb * 32 + (lane & 31), WABt, 2 * D, 0, scr, kb * 64, nb * 32, lane);
        else if (which == 1) p0_tr_item(a.w_out_b, D, nb * 32 + (lane & 31), WABt, 2 * D, D, scr, kb * 64, nb * 32, lane);
        else p0_tr_item(a.w_o, D, nb * 32 + (lane & 31), Wot, D, 0, scr, kb * 64, nb * 32, lane);
    }
}

__device__ __forceinline__ float wave_sum(float v) {
#pragma unroll
    for (int o = 1; o < 64; o <<= 1) v += __shfl_xor(v, o);
    return v;
}
__device__ __forceinline__ void p1_h(const Args& a) {
    const int tid = threadIdx.x, lane = tid & 63, wave = tid >> 6;
    const int gw = blockIdx.x * NWAVES + wave, NGW = gridDim.x * NWAVES;
    const float* part = (const float*)(a.ws + WS_MODP);
    { const int gid = blockIdx.x * NTHREADS + tid; if (gid < NB * D) { const int b = gid >> 10, j = gid & 1023; float s = a.ada_b[2 * D + j];
        for (int kc = 0; kc < 8; ++kc) s += part[(size_t)(kc * 32 + b) * 3072 + 2 * D + j]; ((float*)(a.ws + WS_GATE))[gid] = s; } }
    bf16_t* H = (bf16_t*)(a.ws + WS_H);
    for (int rb = gw; rb < T / 32; rb += NGW) {
        const int b = (rb * 32) / SEQ;
        f32x4 gs[4], sh[4];
#pragma unroll
        for (int j = 0; j < 4; ++j) { const int k = 4 * lane + 256 * j; f32x4 sc = *(const f32x4*)(a.ada_b + D + k), sf = *(const f32x4*)(a.ada_b + k);
            for (int kc = 0; kc < 8; ++kc) { const float* p = part + (size_t)(kc * 32 + b) * 3072; sc += *(const f32x4*)(p + D + k); sf += *(const f32x4*)(p + k); }
            gs[j] = *(const f32x4*)(a.norm_g + k) * (sc + 1.f); sh[j] = sf; }
        for (int r = 0; r < 32; ++r) { const size_t row = (size_t)rb * 32 + r; const f32x4* xr = (const f32x4*)(a.x + row * D) + lane;
            f32x4 v[4]; float s = 0.f;
#pragma unroll
            for (int j = 0; j < 4; ++j) { v[j] = xr[64 * j]; s += (v[j][0] * v[j][0] + v[j][1] * v[j][1]) + (v[j][2] * v[j][2] + v[j][3] * v[j][3]); }
            const float rstd = rsqrtf(wave_sum(s) * (1.f / D) + EPS);
            unsigned long long* o8 = (unsigned long long*)(H + row * D) + lane;
#pragma unroll
            for (int j = 0; j < 4; ++j) { const f32x4 h = v[j] * rstd * gs[j] + sh[j]; o8[64 * j] = (unsigned long long)pk2(h[0], h[1]) | ((unsigned long long)pk2(h[2], h[3]) << 32); } }
    }
}

__device__ __forceinline__ void p5_final(const Args& a) {
    const int tid = threadIdx.x, lane = tid & 63, wave = tid >> 6;
    const int gw = blockIdx.x * NWAVES + wave, NGW = gridDim.x * NWAVES;
    const float* part = (const float*)(a.ws + WS_PART);
    f32x4 fg[4];
#pragma unroll
    for (int j = 0; j < 4; ++j) fg[j] = *(const f32x4*)(a.final_g + 4 * lane + 256 * j);
    for (int row = gw; row < T; row += NGW) {
        float s = part[(size_t)row * 16 + (lane & 15)];
        s += __shfl_xor(s, 1); s += __shfl_xor(s, 2); s += __shfl_xor(s, 4); s += __shfl_xor(s, 8);
        const float rstd = rsqrtf(s * (1.f / D) + EPS);
        f32x4* o = (f32x4*)(a.out + (size_t)row * D) + lane;
#pragma unroll
        for (int j = 0; j < 4; ++j) o[64 * j] = o[64 * j] * rstd * fg[j];
    }
}

__global__ void __launch_bounds__(NTHREADS, 2) mega_fwd(Args a) {
    extern __shared__ __attribute__((aligned(16))) unsigned char lds_raw[];
    LAS unsigned char* lds = (LAS unsigned char*)lds_raw;
    cg::grid_group grid = cg::this_grid();
    const int G = gridDim.x;
    p0_prep(lds, a);
    grid.sync();
    p1_h(a);
    grid.sync();
    { pg8::Gemm g{(const bf16_t*)(a.ws + WS_H), (const bf16_t*)(a.ws + WS_W1T), T, INW, D};
      pg8::StripOrder S{(int)blockIdx.x};
      pg8::EpiMix E{(const float*)(a.ws + WS_BIAS1), a.pool_scale, a.conv_w, a.conv_b, (bf16_t*)(a.ws + WS_Y), (bf16_t*)(a.ws + WS_R), (bf16_t*)(a.ws + WS_SB)};
      pg8::gemm_phase<pg8::EpiMix, pg8::StripOrder, true>(lds, g, S, E); }
    grid.sync();
    { pg8::Gemm g{(const bf16_t*)(a.ws + WS_Y), (const bf16_t*)(a.ws + WS_WABT), T, D, 2 * D};
      pg8::StaticOrder S; S.init(T, D, G, (int)blockIdx.x);
      pg8::EpiMerge E{(const bf16_t*)(a.ws + WS_R), (const bf16_t*)(a.ws + WS_SB), (bf16_t*)(a.ws + WS_H)};
      pg8::gemm_phase<pg8::EpiMerge, pg8::StaticOrder>(lds, g, S, E); }
    grid.sync();
    { pg8::Gemm g{(const bf16_t*)(a.ws + WS_H), (const bf16_t*)(a.ws + WS_WOT), T, D, D};
      pg8::StaticOrder S; S.init(T, D, G, (int)blockIdx.x);
      pg8::EpiXnew E{a.x, (const float*)(a.ws + WS_GATE), a.out, (float*)(a.ws + WS_PART)};
      pg8::gemm_phase<pg8::EpiXnew, pg8::StaticOrder>(lds, g, S, E); }
    grid.sync();
    p5_final(a);
}
}

extern "C" void kernel_launch(void* const* d_in, const int* in_sizes, int n_in, void* d_out, int out_size, void* d_ws, size_t ws_size, hipStream_t stream) {
    static int grid = 0;
    if (grid == 0) {
        if (n_in != 15 || out_size != T * D || ws_size < WS_END) { fprintf(stderr, "kernel_launch: unexpected shapes (n_in %d out %d ws %zu)\n", n_in, out_size, ws_size); grid = -1; return; }
        int dev = 0, cus = 0, per_cu = 0;
        hipGetDevice(&dev); hipDeviceGetAttribute(&cus, hipDeviceAttributeMultiprocessorCount, dev);
        if (hipFuncSetAttribute((const void*)mega_fwd, hipFuncAttributeMaxDynamicSharedMemorySize, LDS_BYTES) != hipSuccess) { fprintf(stderr, "kernel_launch: hipFuncSetAttribute failed\n"); grid = -1; return; }
        if (hipOccupancyMaxActiveBlocksPerMultiprocessor(&per_cu, (const void*)mega_fwd, NTHREADS, LDS_BYTES) != hipSuccess || per_cu < 1) { fprintf(stderr, "kernel_launch: occupancy query failed (%d)\n", per_cu); (void)hipGetLastError(); per_cu = 1; }
        grid = cus * 1;
        if (grid != 256) { fprintf(stderr, "kernel_launch: this kernel's GEMM1 strip order needs exactly 256 CUs (got %d)\n", cus); grid = -1; return; }
        fprintf(stderr, "kernel_launch: %d CUs, occupancy %d/CU, grid %d\n", cus, per_cu, grid);
    }
    if (grid < 0) return;
    Args a{};
    a.x = (const float*)d_in[0]; a.c = (const float*)d_in[1]; a.ada_w = (const float*)d_in[2]; a.ada_b = (const float*)d_in[3]; a.norm_g = (const float*)d_in[4];
    a.w_in = (const float*)d_in[5]; a.b_in = (const float*)d_in[6]; a.pool_w = (const float*)d_in[7]; a.pool_scale = (const float*)d_in[8]; a.conv_w = (const float*)d_in[9];
    a.conv_b = (const float*)d_in[10]; a.w_out_a = (const float*)d_in[11]; a.w_out_b = (const float*)d_in[12]; a.w_o = (const float*)d_in[13]; a.final_g = (const float*)d_in[14];
    a.out = (float*)d_out; a.ws = (unsigned char*)d_ws;
    void* args[] = {&a};
    hipError_t e = hipLaunchCooperativeKernel((const void*)mega_fwd, dim3(grid), dim3(NTHREADS), args, LDS_BYTES, stream);
    if (e != hipSuccess) fprintf(stderr, "kernel_launch: cooperative launch failed: %s (grid %d)\n", hipGetErrorString(e), grid);
}
```
